# Optimizing an MI355X kernel written in HIP

```python
import jax, jax.numpy as jnp
from jax import lax
import numpy as np

D_MODEL = 1024
BATCH = 1
SEQ = 16384
DEPTH = 2

N_EVEN = (DEPTH + 1) // 2
N_ODD = DEPTH // 2
EPS = 1e-6
ROPE_THETA = 500000.0
Q_BLOCK = 128

MOBA_HEADS = 8
MOBA_HEAD_DIM = 64
MOBA_ROT = MOBA_HEAD_DIM // 4
MOBA_BLOCK = 256
MOBA_TOPK = 3
RET_HEADS = 8
RET_DK = 64
RET_DV = 128
RET_CHUNK = 128
RET_THETA = 10000.0
MOBA_W = MOBA_HEADS * MOBA_HEAD_DIM
RET_QK_W = RET_HEADS * RET_DK
RET_V_W = RET_HEADS * RET_DV
EVEN_IN = 3 * MOBA_W + 2 * RET_QK_W + 2 * RET_V_W
EVEN_OUT = MOBA_W + RET_V_W
MLA_HEADS = 16
MLA_NOPE = 64
MLA_ROPE = 32
MLA_V = 64
MLA_Q_RANK = 512
MLA_KV_RANK = 256
MLA_DOWN = MLA_Q_RANK + MLA_KV_RANK + MLA_ROPE
PEER_HEADS = 8
PEER_NKEYS = 128
PEER_EXPERTS = PEER_NKEYS * PEER_NKEYS
PEER_DKEY = 128
PEER_TOPK = 16
PEER_CHUNK = 128

kernel_name = "hybrid_moba_retnet_mla_peer"


def rmsnorm(x, g):
    xf = x.astype(jnp.float32)
    y = xf * lax.rsqrt(jnp.mean(xf * xf, axis=-1, keepdims=True) + EPS)
    return (y * g).astype(x.dtype)


def rope_angles(S, rot_dim, theta):
    inv = 1.0 / (theta ** (jnp.arange(0, rot_dim, 2, dtype=jnp.float32) / rot_dim))
    ang = jnp.arange(S, dtype=jnp.float32)[:, None] * inv[None, :]
    return jnp.cos(ang), jnp.sin(ang)


def apply_rope(x, cos, sin):
    r2 = x.shape[-1] // 2
    x1, x2 = x[..., :r2], x[..., r2:]
    c = cos[None, :, None, :]
    s = sin[None, :, None, :]
    return jnp.concatenate([x1 * c - x2 * s, x2 * c + x1 * s], axis=-1).astype(x.dtype)


def partial_rope(x, cos, sin, rot):
    return jnp.concatenate([apply_rope(x[..., :rot], cos, sin), x[..., rot:]], axis=-1)


def moba_attention(q, k, v):
    B, S, H, D = q.shape
    pad = (-S) % MOBA_BLOCK
    padw = ((0, 0), (0, pad), (0, 0), (0, 0))
    q, k, v = jnp.pad(q, padw), jnp.pad(k, padw), jnp.pad(v, padw)
    Sp = S + pad
    nb = Sp // MOBA_BLOCK
    nq = Sp // Q_BLOCK
    kb = k.reshape(B, nb, MOBA_BLOCK, H, D).transpose(0, 3, 1, 2, 4)
    vb = v.reshape(B, nb, MOBA_BLOCK, H, D).transpose(0, 3, 1, 2, 4)
    kmean = jnp.mean(kb.astype(jnp.float32), axis=3)
    n_sel = min(MOBA_TOPK, nb - 1)
    scale = D ** -0.5
    bi = jnp.arange(B)[:, None, None, None]
    hi = jnp.arange(H)[None, :, None, None]

    def one_block(c):
        q0 = c * Q_BLOCK
        qs = lax.dynamic_slice_in_dim(q, q0, Q_BLOCK, axis=1)
        blk = q0 // MOBA_BLOCK
        qpos = q0 + jnp.arange(Q_BLOCK)
        kpos = blk * MOBA_BLOCK + jnp.arange(MOBA_BLOCK)
        kown = lax.dynamic_index_in_dim(kb, blk, axis=2, keepdims=False)
        vown = lax.dynamic_index_in_dim(vb, blk, axis=2, keepdims=False)
        s_own = jnp.einsum("bqhd,bhkd->bhqk", qs, kown).astype(jnp.float32) * scale
        s_own = jnp.where(kpos[None, :] <= qpos[:, None], s_own, -jnp.inf)
        if n_sel == 0:
            p = jax.nn.softmax(s_own, axis=-1)
            return jnp.einsum("bhqk,bhkd->bqhd", p, vown)
        gate = jnp.einsum("bqhd,bhnd->bhqn", qs.astype(jnp.float32), kmean)
        gate = jnp.where(jnp.arange(nb) < blk, gate, -jnp.inf)
        _, idx = lax.top_k(gate, n_sel)
        ksel = kb[bi, hi, idx]
        vsel = vb[bi, hi, idx]
        s_sel = jnp.einsum("bqhd,bhqnkd->bhqnk", qs, ksel).astype(jnp.float32) * scale
        valid = jnp.arange(n_sel) < blk
        s_sel = jnp.where(valid[:, None], s_sel, -jnp.inf).reshape(B, H, Q_BLOCK, n_sel * MOBA_BLOCK)
        p = jax.nn.softmax(jnp.concatenate([s_sel, s_own], axis=-1), axis=-1)
        p_sel = p[..., : n_sel * MOBA_BLOCK].reshape(B, H, Q_BLOCK, n_sel, MOBA_BLOCK)
        p_own = p[..., n_sel * MOBA_BLOCK:]
        return (jnp.einsum("bhqnk,bhqnkd->bqhd", p_sel, vsel)
                + jnp.einsum("bhqk,bhkd->bqhd", p_own, vown))

    o = lax.map(one_block, jnp.arange(nq))
    return o.transpose(1, 0, 2, 3, 4).reshape(B, Sp, H, D)[:, :S]


def retention_chunkwise(q, k, v):
    B, S, H, dk = q.shape
    dv = v.shape[-1]
    C = RET_CHUNK
    n = S // C
    log_g = jnp.log(1.0 - 2.0 ** (-5.0 - jnp.arange(H, dtype=jnp.float32)))
    pos = jnp.arange(C, dtype=jnp.float32)
    diff = pos[:, None] - pos[None, :]
    dmat = jnp.where(diff >= 0, jnp.exp(log_g[:, None, None] * jnp.maximum(diff, 0.0)), 0.0)
    xi = jnp.exp(log_g[:, None] * (pos + 1.0))[None, :, :, None]
    zeta = jnp.exp(log_g[:, None] * (C - 1.0 - pos))[None, :, :, None]
    g_chunk = jnp.exp(log_g * C)[None, :, None, None]

    def to_chunks(t):
        return t.astype(jnp.float32).reshape(B, n, C, H, t.shape[-1]).transpose(1, 0, 3, 2, 4)

    def body(R, xs):
        qi, ki, vi = xs
        inner = jnp.einsum("bhnd,bhmd->bhnm", qi, ki) * dmat[None]
        out = jnp.einsum("bhnm,bhme->bhne", inner, vi) + jnp.einsum("bhnd,bhde->bhne", qi, R) * xi
        R_new = R * g_chunk + jnp.einsum("bhmd,bhme->bhde", ki * zeta, vi)
        return R_new, out

    R0 = jnp.zeros((B, H, dk, dv), jnp.float32)
    _, o = lax.scan(body, R0, (to_chunks(q), to_chunks(k), to_chunks(v)))
    return o.transpose(1, 0, 3, 2, 4).reshape(B, S, H, dv)


def causal_attention_blocked(q, k, v):
    B, S, H, dq = q.shape
    nq = S // Q_BLOCK
    scale = dq ** -0.5
    kpos = jnp.arange(S)

    def one_block(c):
        q0 = c * Q_BLOCK
        qs = lax.dynamic_slice_in_dim(q, q0, Q_BLOCK, axis=1)
        s = jnp.einsum("bqhd,bkhd->bhqk", qs, k).astype(jnp.float32) * scale
        qpos = q0 + jnp.arange(Q_BLOCK)
        s = jnp.where(kpos[None, :] <= qpos[:, None], s, -jnp.inf)
        p = jax.nn.softmax(s, axis=-1)
        return jnp.einsum("bhqk,bkhd->bqhd", p, v)

    o = lax.map(one_block, jnp.arange(nq))
    return o.transpose(1, 0, 2, 3, 4).reshape(B, S, H, v.shape[-1])


def even_mixer(h, w_in, ret_gn, w_o):
    B, S, _ = h.shape
    proj = h @ w_in
    splits = [MOBA_W, 2 * MOBA_W, 3 * MOBA_W, 3 * MOBA_W + RET_QK_W,
              3 * MOBA_W + 2 * RET_QK_W, 3 * MOBA_W + 2 * RET_QK_W + RET_V_W]
    mq, mk, mv, rq, rk, rv, rg = jnp.split(proj, splits, axis=-1)
    cos_m, sin_m = rope_angles(S, MOBA_ROT, ROPE_THETA)
    mq = partial_rope(mq.reshape(B, S, MOBA_HEADS, MOBA_HEAD_DIM), cos_m, sin_m, MOBA_ROT)
    mk = partial_rope(mk.reshape(B, S, MOBA_HEADS, MOBA_HEAD_DIM), cos_m, sin_m, MOBA_ROT)
    mv = mv.reshape(B, S, MOBA_HEADS, MOBA_HEAD_DIM)
    a_out = moba_attention(mq, mk, mv).reshape(B, S, MOBA_W)
    cos_r, sin_r = rope_angles(S, RET_DK, RET_THETA)
    rq = apply_rope(rq.reshape(B, S, RET_HEADS, RET_DK), cos_r, sin_r)
    rk = apply_rope(rk.reshape(B, S, RET_HEADS, RET_DK), cos_r, sin_r) * (RET_DK ** -0.5)
    rv = rv.reshape(B, S, RET_HEADS, RET_DV)
    r = retention_chunkwise(rq, rk, rv)
    mu = jnp.mean(r, axis=-1, keepdims=True)
    var = jnp.mean(jnp.square(r - mu), axis=-1, keepdims=True)
    r = ((r - mu) * lax.rsqrt(var + EPS)) * ret_gn.reshape(RET_HEADS, RET_DV)
    b_out = r.reshape(B, S, RET_V_W) * jax.nn.silu(rg.astype(jnp.float32))
    cat = jnp.concatenate([a_out.astype(jnp.float32), b_out], axis=-1).astype(h.dtype)
    return cat @ w_o


def odd_mixer(h, w_down, q_norm, w_uq, kv_norm, w_ukv, w_o):
    B, S, _ = h.shape
    down = h @ w_down
    cq, ckv, kr = jnp.split(down, [MLA_Q_RANK, MLA_Q_RANK + MLA_KV_RANK], axis=-1)
    cq = rmsnorm(cq, q_norm)
    ckv = rmsnorm(ckv, kv_norm)
    q = (cq @ w_uq).reshape(B, S, MLA_HEADS, MLA_NOPE + MLA_ROPE)
    cos, sin = rope_angles(S, MLA_ROPE, ROPE_THETA)
    q_rope = apply_rope(q[..., MLA_NOPE:], cos, sin)
    k_rope = apply_rope(kr[:, :, None, :], cos, sin)
    kv = (ckv @ w_ukv).reshape(B, S, MLA_HEADS, MLA_NOPE + MLA_V)
    k_nope, v = kv[..., :MLA_NOPE], kv[..., MLA_NOPE:]
    qf = jnp.concatenate([q[..., :MLA_NOPE], q_rope], axis=-1)
    kf = jnp.concatenate([k_nope, jnp.broadcast_to(k_rope, (B, S, MLA_HEADS, MLA_ROPE)).astype(k_nope.dtype)], axis=-1)
    o = causal_attention_blocked(qf, kf, v)
    return o.reshape(B, S, MLA_HEADS * MLA_V).astype(h.dtype) @ w_o


def peer_ffn(x, w_q, sub_keys, u_tab, v_tab):
    B, S, D = x.shape
    T = B * S
    KK = PEER_TOPK * PEER_TOPK
    xt = x.reshape(T, D)
    qry = (xt @ w_q).reshape(T, PEER_HEADS, 2, PEER_DKEY // 2).astype(jnp.float32)
    s = jnp.einsum("thpd,hpnd->thpn", qry, sub_keys.astype(jnp.float32))
    s1, i1 = lax.top_k(s[:, :, 0], PEER_TOPK)
    s2, i2 = lax.top_k(s[:, :, 1], PEER_TOPK)
    cand = (s1[..., :, None] + s2[..., None, :]).reshape(T, PEER_HEADS, KK)
    cidx = (i1[..., :, None] * PEER_NKEYS + i2[..., None, :]).reshape(T, PEER_HEADS, KK)
    top_s, pos = lax.top_k(cand, PEER_TOPK)
    eidx = jnp.take_along_axis(cidx, pos, axis=-1)
    gate = jax.nn.softmax(top_s, axis=-1)
    nc = T // PEER_CHUNK

    def chunk(args):
        xc, ec, gc = args
        ue = u_tab[ec]
        ve = v_tab[ec]
        a = jax.nn.gelu(jnp.einsum("td,thkd->thk", xc, ue), approximate=False) * gc
        return jnp.einsum("thk,thkd->td", a, ve)

    out = lax.map(chunk, (xt.reshape(nc, PEER_CHUNK, D),
                          eidx.reshape(nc, PEER_CHUNK, PEER_HEADS, PEER_TOPK),
                          gate.reshape(nc, PEER_CHUNK, PEER_HEADS, PEER_TOPK)))
    return out.reshape(B, S, D).astype(x.dtype)


def setup_inputs(seed: int = 0) -> dict:
    key = jax.random.key(seed)
    ks = jax.random.split(key, 17)
    f32 = jnp.float32

    def nrm(k, shape, scale):
        return jax.random.normal(k, shape, f32) * scale

    def gain(k, shape):
        return 1.0 + 0.02 * jax.random.normal(k, shape, f32)

    return {
        "x": nrm(ks[0], (BATCH, SEQ, D_MODEL), 1.0),
        "attn_norm": gain(ks[1], (DEPTH, D_MODEL)),
        "ffn_norm": gain(ks[2], (DEPTH, D_MODEL)),
        "ev_w_in": nrm(ks[3], (N_EVEN, D_MODEL, EVEN_IN), D_MODEL ** -0.5),
        "ev_ret_gn": gain(ks[4], (N_EVEN, RET_V_W)),
        "ev_w_o": nrm(ks[5], (N_EVEN, EVEN_OUT, D_MODEL), EVEN_OUT ** -0.5),
        "od_w_down": nrm(ks[6], (N_ODD, D_MODEL, MLA_DOWN), D_MODEL ** -0.5),
        "od_q_norm": gain(ks[7], (N_ODD, MLA_Q_RANK)),
        "od_w_uq": nrm(ks[8], (N_ODD, MLA_Q_RANK, MLA_HEADS * (MLA_NOPE + MLA_ROPE)), MLA_Q_RANK ** -0.5),
        "od_kv_norm": gain(ks[9], (N_ODD, MLA_KV_RANK)),
        "od_w_ukv": nrm(ks[10], (N_ODD, MLA_KV_RANK, MLA_HEADS * (MLA_NOPE + MLA_V)), MLA_KV_RANK ** -0.5),
        "od_w_o": nrm(ks[11], (N_ODD, MLA_HEADS * MLA_V, D_MODEL), (MLA_HEADS * MLA_V) ** -0.5),
        "peer_wq": nrm(ks[12], (DEPTH, D_MODEL, PEER_HEADS * PEER_DKEY), D_MODEL ** -0.5),
        "peer_keys": nrm(ks[13], (DEPTH, PEER_HEADS, 2, PEER_NKEYS, PEER_DKEY // 2), (PEER_DKEY // 2) ** -0.5),
        "peer_u": nrm(ks[14], (DEPTH, PEER_EXPERTS, D_MODEL), D_MODEL ** -0.5),
        "peer_v": nrm(ks[15], (DEPTH, PEER_EXPERTS, D_MODEL), PEER_HEADS ** -0.5),
        "final_norm": gain(ks[16], (D_MODEL,)),
    }


def reference(x, attn_norm, ffn_norm, ev_w_in, ev_ret_gn, ev_w_o, od_w_down, od_q_norm, od_w_uq,
              od_kv_norm, od_w_ukv, od_w_o, peer_wq, peer_keys, peer_u, peer_v, final_norm):
    h = x
    for i in range(DEPTH):
        hn = rmsnorm(h, attn_norm[i])
        j = i // 2
        if i % 2 == 0:
            mix = even_mixer(hn, ev_w_in[j], ev_ret_gn[j], ev_w_o[j])
        else:
            mix = odd_mixer(hn, od_w_down[j], od_q_norm[j], od_w_uq[j], od_kv_norm[j], od_w_ukv[j], od_w_o[j])
        h = h + mix.astype(h.dtype)
        h = h + peer_ffn(rmsnorm(h, ffn_norm[i]), peer_wq[i], peer_keys[i], peer_u[i], peer_v[i])
    return rmsnorm(h, final_norm).astype(x.dtype)
```

```cpp
#include <hip/hip_runtime.h>
#include <hip/hip_cooperative_groups.h>
#include <cstdio>
#include <cstdint>
#include <cstring>
namespace cg = cooperative_groups;

#ifndef MEGA
#define MEGA 1
#endif

typedef unsigned short bf16_t;
typedef unsigned long long u64;

#define T_ 16384
#define DM 1024
#define EVEN_IN 4608
#define NTHREADS 256
#define MOBA_LSTRIDE 16384
#define ATT_THR 6.0f
#define MOBA_QSCALE (0.125f * 1.4426950408889634f)
#define MLA_QSCALE (0.10206207261596575f * 1.4426950408889634f)

__device__ __forceinline__ int tidx() {
  int t = __builtin_amdgcn_workitem_id_x();
  asm volatile("" : "+v"(t));
  return t;
}
__device__ __forceinline__ float bf2f(bf16_t b) { return __uint_as_float(((unsigned)b) << 16); }
__device__ __forceinline__ bf16_t f2bf(float f) {
  unsigned u = __float_as_uint(f);
  u += 0x7fffu + ((u >> 16) & 1u);
  return (bf16_t)(u >> 16);
}
typedef __attribute__((ext_vector_type(2))) float f32x2_t;
typedef __attribute__((ext_vector_type(2))) __bf16 bf16x2_t;
__device__ __forceinline__ unsigned pack2(float lo, float hi) {
  f32x2_t v = {lo, hi};
  bf16x2_t r = __builtin_convertvector(v, bf16x2_t);
  return __builtin_bit_cast(unsigned, r);
}
__device__ __forceinline__ float wave_sum(float v) {
#pragma unroll
  for (int o = 32; o > 0; o >>= 1) v += __shfl_xor(v, o);
  return v;
}
__device__ __forceinline__ float wave_max(float v) {
#pragma unroll
  for (int o = 32; o > 0; o >>= 1) v = fmaxf(v, __shfl_xor(v, o));
  return v;
}

struct Params {
  const float *x, *attn_norm, *ffn_norm, *ev_w_in, *ev_ret_gn, *ev_w_o, *od_w_down, *od_q_norm, *od_w_uq, *od_kv_norm,
      *od_w_ukv, *od_w_o, *peer_wq, *peer_keys, *peer_u, *peer_v, *final_norm;
  float* out;
  bf16_t *WT_in, *WT_o0, *WT_down, *WT_uq, *WT_ukv, *WT_o1, *WT_pq;
  bf16_t* PKEYS;
  unsigned char *PU8, *PV8;
  float* PUS;
  float *COSM, *SINM, *COSR, *SINR, *COSL, *SINL;
  bf16_t* XN;
  unsigned* BAR;
  unsigned *GCNT, *MLIST;
  float *SSQ0, *SSQ1, *SSQQ, *SSQKV;
  bf16_t* PO;
  float* PML;
  int* EIDX;
  float* GATE;
  bf16_t *MQ, *MK, *MVT, *RQ, *RK, *RKTZ, *RVT, *RG, *CAT, *RT;
  float* SST;
  float* KMEAN;
  bf16_t *CQN, *CKVN, *Q1, *K1, *V1T, *O1;
};

__device__ __forceinline__ void transpose_w(const float* __restrict__ src, int K, int N, bf16_t* __restrict__ dst, int Npad, float* tile,
                            int bid, int nb, const float* __restrict__ gk = nullptr) {
  const int tilesN = Npad / 32, tilesK = K / 32;
  const int c = tidx() & 31, r = tidx() >> 5;
  for (int it = bid; it < tilesN * tilesK; it += nb) {
    const int tn = it % tilesN, tk = it / tilesN;
#pragma unroll
    for (int i = 0; i < 4; i++) {
      const int k = tk * 32 + r + 8 * i, n = tn * 32 + c;
      tile[(r + 8 * i) * 33 + c] = (n < N) ? src[(size_t)k * N + n] * (gk ? gk[k] : 1.f) : 0.f;
    }
    __syncthreads();
#pragma unroll
    for (int i = 0; i < 4; i++) {
      const int n = tn * 32 + r + 8 * i, k = tk * 32 + c;
      dst[(size_t)n * K + k] = f2bf(tile[c * 33 + r + 8 * i]);
    }
    __syncthreads();
  }
}

__device__ __forceinline__ void convert_bf16(const float* __restrict__ src, bf16_t* __restrict__ dst, size_t n, int bid, int nb) {
  const size_t nvec = n / 8;
  for (size_t i = (size_t)bid * NTHREADS + tidx(); i < nvec; i += (size_t)nb * NTHREADS) {
    const float4 a = ((const float4*)src)[2 * i], b = ((const float4*)src)[2 * i + 1];
    uint4 o;
    o.x = pack2(a.x, a.y);
    o.y = pack2(a.z, a.w);
    o.z = pack2(b.x, b.y);
    o.w = pack2(b.z, b.w);
    ((uint4*)dst)[i] = o;
  }
}

__device__ __forceinline__ void rope_tables(float* cs, float* sn, int half, double theta, int bid, int nb) {
  const int total = T_ * half;
  for (int idx = bid * NTHREADS + tidx(); idx < total; idx += nb * NTHREADS) {
    const int t = idx / half, i = idx % half;
    const double inv = exp(-((double)i / (double)half) * log(theta));
    double rev = (double)t * inv * 0.15915494309189535;
    rev -= rint(rev);
    const float r = (float)(rev * 6.283185307179586);
    cs[idx] = __cosf(r);
    sn[idx] = __sinf(r);
  }
}

__device__ __forceinline__ void rmsnorm_rows(const float* __restrict__ in, const float* __restrict__ g, bf16_t* __restrict__ outb, int bid,
                             int nb, float* __restrict__ outf = nullptr) {
  const int lane = tidx() & 63, wid = tidx() >> 6;
  for (int row = bid * 4 + wid; row < T_; row += nb * 4) {
    const float* r = in + (size_t)row * DM;
    float4 v[4];
    float ss = 0.f;
#pragma unroll
    for (int j = 0; j < 4; j++) {
      v[j] = *(const float4*)(r + lane * 4 + 256 * j);
      ss += v[j].x * v[j].x + v[j].y * v[j].y + v[j].z * v[j].z + v[j].w * v[j].w;
    }
    ss = wave_sum(ss);
    const float sc = rsqrtf(ss * (1.f / DM) + 1e-6f);
#pragma unroll
    for (int j = 0; j < 4; j++) {
      const float4 gg = *(const float4*)(g + lane * 4 + 256 * j);
      uint2 o;
      o.x = pack2(v[j].x * sc * gg.x, v[j].y * sc * gg.y);
      o.y = pack2(v[j].z * sc * gg.z, v[j].w * sc * gg.w);
      *(uint2*)(outb + (size_t)row * DM + lane * 4 + 256 * j) = o;
      if (outf)
        *(float4*)(outf + (size_t)row * DM + lane * 4 + 256 * j) =
            make_float4(v[j].x * sc * gg.x, v[j].y * sc * gg.y, v[j].z * sc * gg.z, v[j].w * sc * gg.w);
    }
  }
}

typedef __attribute__((ext_vector_type(8))) short bf16x8;
typedef __attribute__((ext_vector_type(4))) float f32x4;
typedef __attribute__((ext_vector_type(16))) float f32x16;

#define GEMM_LDS_BYTES 65536

__device__ __forceinline__ float ret_log2g(int h);
__device__ __forceinline__ void store8bf(bf16_t* dst, const float* v) {
  uint4 o;
  o.x = pack2(v[0], v[1]); o.y = pack2(v[2], v[3]); o.z = pack2(v[4], v[5]); o.w = pack2(v[6], v[7]);
  *(uint4*)dst = o;
}
__device__ __forceinline__ void store8T(bf16_t* dst, int f0, int t, const float* v) {
#pragma unroll
  for (int j = 0; j < 8; j += 2) {
    const unsigned w = pack2(v[j], v[j + 1]);
    dst[(size_t)(f0 + j) * T_ + t] = (bf16_t)(w & 0xffffu);
    dst[(size_t)(f0 + j + 1) * T_ + t] = (bf16_t)(w >> 16);
  }
}

struct EpiInProj {
  bf16_t *MQ, *MK, *MVT, *RQ, *RK, *RKTZ, *RVT, *RG;
  const float *COSM, *SINM, *COSR, *SINR;
  static constexpr int NK = 5;
  __device__ __forceinline__ int kind(int nb) const {
    return (nb < 1024) ? 0 : (nb < 1536) ? 1 : (nb < 2560) ? 2 : (nb < 3584) ? 3 : 4;
  }
  template <int KD>
  __device__ __forceinline__ void tok(int t, int nb, int q, float* v0, float* v1) const {
    if constexpr (KD == 0) {
      float pr[8];
#pragma unroll
      for (int j = 0; j < 8; j++) pr[j] = __shfl_xor(v0[j], 16);
      if (q < 2) {
        const float4 c0 = *(const float4*)(COSM + t * 8), c1 = *(const float4*)(COSM + t * 8 + 4);
        const float4 s0 = *(const float4*)(SINM + t * 8), s1 = *(const float4*)(SINM + t * 8 + 4);
        const float cs[8] = {c0.x, c0.y, c0.z, c0.w, c1.x, c1.y, c1.z, c1.w};
        const float sn[8] = {s0.x, s0.y, s0.z, s0.w, s1.x, s1.y, s1.z, s1.w};
        const float sg = (q == 0) ? -1.f : 1.f;
#pragma unroll
        for (int j = 0; j < 8; j++) v0[j] = v0[j] * cs[j] + sg * pr[j] * sn[j];
      }
      if (nb < 512) {
#pragma unroll
        for (int j = 0; j < 8; j++) { v0[j] *= MOBA_QSCALE; v1[j] *= MOBA_QSCALE; }
        store8bf(MQ + (size_t)t * 512 + nb + 8 * q, v0);
        store8bf(MQ + (size_t)t * 512 + nb + 32 + 8 * q, v1);
      } else {
        store8bf(MK + (size_t)t * 512 + (nb - 512) + 8 * q, v0);
        store8bf(MK + (size_t)t * 512 + (nb - 512) + 32 + 8 * q, v1);
      }
    } else if constexpr (KD == 1) {
      store8T(MVT, nb - 1024 + 8 * q, t, v0);
      store8T(MVT, nb - 1024 + 32 + 8 * q, t, v1);
    } else if constexpr (KD == 2) {
      const float4 c0 = *(const float4*)(COSR + t * 32 + 8 * q), c1 = *(const float4*)(COSR + t * 32 + 8 * q + 4);
      const float4 s0 = *(const float4*)(SINR + t * 32 + 8 * q), s1 = *(const float4*)(SINR + t * 32 + 8 * q + 4);
      const float cs[8] = {c0.x, c0.y, c0.z, c0.w, c1.x, c1.y, c1.z, c1.w};
      const float sn[8] = {s0.x, s0.y, s0.z, s0.w, s1.x, s1.y, s1.z, s1.w};
      float a[8], b[8];
#pragma unroll
      for (int j = 0; j < 8; j++) {
        a[j] = v0[j] * cs[j] - v1[j] * sn[j];
        b[j] = v1[j] * cs[j] + v0[j] * sn[j];
      }
      if (nb < 2048) {
        store8bf(RQ + (size_t)t * 512 + (nb - 1536) + 8 * q, a);
        store8bf(RQ + (size_t)t * 512 + (nb - 1536) + 32 + 8 * q, b);
      } else {
        const int hh = (nb - 2048) >> 6;
        const float zeta = exp2f(ret_log2g(hh) * (float)(127 - (t & 127)));
#pragma unroll
        for (int j = 0; j < 8; j++) { a[j] *= 0.125f; b[j] *= 0.125f; }
        store8bf(RK + (size_t)t * 512 + (nb - 2048) + 8 * q, a);
        store8bf(RK + (size_t)t * 512 + (nb - 2048) + 32 + 8 * q, b);
#pragma unroll
        for (int j = 0; j < 8; j++) { a[j] *= zeta; b[j] *= zeta; }
        store8T(RKTZ, nb - 2048 + 8 * q, t, a);
        store8T(RKTZ, nb - 2048 + 32 + 8 * q, t, b);
      }
    } else if constexpr (KD == 3) {
      store8T(RVT, nb - 2560 + 8 * q, t, v0);
      store8T(RVT, nb - 2560 + 32 + 8 * q, t, v1);
    } else {
      store8bf(RG + (size_t)t * 1024 + (nb - 3584) + 8 * q, v0);
      store8bf(RG + (size_t)t * 1024 + (nb - 3584) + 32 + 8 * q, v1);
    }
  }
};

__device__ __forceinline__ void ssq_store(float* ssqp, int t, int slot, int q, float part) {
  part += __shfl_xor(part, 16);
  part += __shfl_xor(part, 32);
  if (q == 0) ssqp[(size_t)t * 16 + slot] = part;
}
template <int NSLOT>
__device__ __forceinline__ float ssq_sum(const float* ssqp, int t) {
  float s = 0.f;
#pragma unroll
  for (int i = 0; i < NSLOT; i += 4) {
    const float4 v = *(const float4*)(ssqp + (size_t)t * 16 + i);
    s += (v.x + v.y) + (v.z + v.w);
  }
  return s;
}
struct EpiUQ {
  bf16_t* Q1;
  const float *COSL, *SINL;
  const float* SSQQ;
  __device__ __forceinline__ void rope32(int t, int n32, int q, float* v) const {
    float pr[8];
#pragma unroll
    for (int j = 0; j < 8; j++) pr[j] = __shfl_xor(v[j], 32);
    if ((n32 >> 5) % 3 == 2) {
      const int i0 = (8 * q) & 15;
      const float4 c0 = *(const float4*)(COSL + t * 16 + i0), c1 = *(const float4*)(COSL + t * 16 + i0 + 4);
      const float4 s0 = *(const float4*)(SINL + t * 16 + i0), s1 = *(const float4*)(SINL + t * 16 + i0 + 4);
      const float cs[8] = {c0.x, c0.y, c0.z, c0.w, c1.x, c1.y, c1.z, c1.w};
      const float sn[8] = {s0.x, s0.y, s0.z, s0.w, s1.x, s1.y, s1.z, s1.w};
      const float sg = (q < 2) ? -1.f : 1.f;
#pragma unroll
      for (int j = 0; j < 8; j++) v[j] = v[j] * cs[j] + sg * pr[j] * sn[j];
    }
    const float sc = MLA_QSCALE * rsqrtf(ssq_sum<8>(SSQQ, t) * (1.f / 512.f) + 1e-6f);
#pragma unroll
    for (int j = 0; j < 8; j++) v[j] *= sc;
    store8bf(Q1 + (size_t)t * 1536 + n32 + 8 * q, v);
  }
  static constexpr int NK = 1;
  __device__ __forceinline__ int kind(int) const { return 0; }
  template <int KD>
  __device__ __forceinline__ void tok(int t, int nb, int q, float* v0, float* v1) const {
    rope32(t, nb, q, v0);
    rope32(t, nb + 32, q, v1);
  }
};

struct EpiUKV {
  bf16_t *K1, *V1T;
  const float* SSQKV;
  static constexpr int NK = 2;
  __device__ __forceinline__ int kind(int nb) const { return (nb >> 6) & 1; }
  template <int KD>
  __device__ __forceinline__ void tok(int t, int nb, int q, float* v0, float* v1) const {
    const int h = nb >> 7;
    const float sc = rsqrtf(ssq_sum<4>(SSQKV, t) * (1.f / 256.f) + 1e-6f);
#pragma unroll
    for (int j = 0; j < 8; j++) { v0[j] *= sc; v1[j] *= sc; }
    if constexpr (KD == 0) {
      store8bf(K1 + (size_t)t * 1536 + h * 96 + 8 * q, v0);
      store8bf(K1 + (size_t)t * 1536 + h * 96 + 32 + 8 * q, v1);
    } else {
      store8T(V1T, h * 64 + 8 * q, t, v0);
      store8T(V1T, h * 64 + 32 + 8 * q, t, v1);
    }
  }
};

struct EpiResSSQ {
  const float* res;
  float* out;
  bf16_t* hb;
  float* ssq;
  static constexpr int NK = 1;
  __device__ __forceinline__ int kind(int) const { return 0; }
  template <int KD>
  __device__ __forceinline__ void tok(int t, int nb, int q, float* v0, float* v1) const {
    const size_t o0 = (size_t)t * 1024 + nb + 8 * q, o1 = o0 + 32;
    const float4 a0 = *(const float4*)(res + o0), a1 = *(const float4*)(res + o0 + 4);
    const float4 b0 = *(const float4*)(res + o1), b1 = *(const float4*)(res + o1 + 4);
    v0[0] += a0.x; v0[1] += a0.y; v0[2] += a0.z; v0[3] += a0.w; v0[4] += a1.x; v0[5] += a1.y; v0[6] += a1.z; v0[7] += a1.w;
    v1[0] += b0.x; v1[1] += b0.y; v1[2] += b0.z; v1[3] += b0.w; v1[4] += b1.x; v1[5] += b1.y; v1[6] += b1.z; v1[7] += b1.w;
    *(float4*)(out + o0) = make_float4(v0[0], v0[1], v0[2], v0[3]);
    *(float4*)(out + o0 + 4) = make_float4(v0[4], v0[5], v0[6], v0[7]);
    *(float4*)(out + o1) = make_float4(v1[0], v1[1], v1[2], v1[3]);
    *(float4*)(out + o1 + 4) = make_float4(v1[4], v1[5], v1[6], v1[7]);
    store8bf(hb + o0, v0);
    store8bf(hb + o1, v1);
    float part = 0.f;
#pragma unroll
    for (int j = 0; j < 8; j++) part += v0[j] * v0[j] + v1[j] * v1[j];
    ssq_store(ssq, t, nb >> 6, q, part);
  }
};
struct EpiDown {
  bf16_t *CQN, *CKVN, *K1;
  float *SSQQ, *SSQKV;
  const float *COSL, *SINL;
  static constexpr int NK = 3;
  __device__ __forceinline__ int kind(int nb) const { return (nb < 512) ? 0 : (nb < 768) ? 1 : 2; }
  template <int KD>
  __device__ __forceinline__ void tok(int t, int nb, int q, float* v0, float* v1) const {
    if constexpr (KD == 0 || KD == 1) {
      bf16_t* dst = (KD == 0) ? (CQN + (size_t)t * 512 + nb) : (CKVN + (size_t)t * 256 + (nb - 512));
      store8bf(dst + 8 * q, v0);
      store8bf(dst + 32 + 8 * q, v1);
      float part = 0.f;
#pragma unroll
      for (int j = 0; j < 8; j++) part += v0[j] * v0[j] + v1[j] * v1[j];
      ssq_store((KD == 0) ? SSQQ : SSQKV, t, (KD == 0) ? (nb >> 6) : ((nb - 512) >> 6), q, part);
    } else {
      float pr[8];
#pragma unroll
      for (int j = 0; j < 8; j++) pr[j] = __shfl_xor(v0[j], 32);
      if (nb == 768) {
        const int i0 = (8 * q) & 15;
        const float4 c0 = *(const float4*)(COSL + t * 16 + i0), c1 = *(const float4*)(COSL + t * 16 + i0 + 4);
        const float4 s0 = *(const float4*)(SINL + t * 16 + i0), s1 = *(const float4*)(SINL + t * 16 + i0 + 4);
        const float cs[8] = {c0.x, c0.y, c0.z, c0.w, c1.x, c1.y, c1.z, c1.w};
        const float sn[8] = {s0.x, s0.y, s0.z, s0.w, s1.x, s1.y, s1.z, s1.w};
        const float sg = (q < 2) ? -1.f : 1.f;
        float o[8];
#pragma unroll
        for (int j = 0; j < 8; j++) o[j] = v0[j] * cs[j] + sg * pr[j] * sn[j];
        uint4 w;
        w.x = pack2(o[0], o[1]); w.y = pack2(o[2], o[3]); w.z = pack2(o[4], o[5]); w.w = pack2(o[6], o[7]);
#pragma unroll
        for (int hh = 0; hh < 16; hh++) *(uint4*)(K1 + (size_t)t * 1536 + hh * 96 + 64 + 8 * q) = w;
      }
    }
  }
};

__device__ __forceinline__ void route_unit(const Params& p, const bf16_t* keys, int h, int t0, const bf16_t* qrow,
                                           unsigned char* ltab);
#define RQ_STRIDE 136
struct EpiRoute {
  const Params* pp;
  const float* ssq;
  int layer;
  char* smem;
  static constexpr int NK = 1;
  static constexpr bool TILE_HOOK = true;
  __device__ __forceinline__ int kind(int) const { return 0; }
  template <int KD>
  __device__ __forceinline__ void tok(int t, int nb, int q, float* v0, float* v1) const {
    const float sc = rsqrtf(ssq_sum<16>(ssq, t) * (1.f / 1024.f) + 1e-6f);
#pragma unroll
    for (int j = 0; j < 8; j++) { v0[j] *= sc; v1[j] *= sc; }
    bf16_t* row = (bf16_t*)smem + (t & 127) * RQ_STRIDE + (nb & 127);
    store8bf(row + 8 * q, v0);
    store8bf(row + 32 + 8 * q, v1);
  }
  __device__ __forceinline__ void tile_hook(int m0, int n0) const {
    __syncthreads();
    const int lane = tidx() & 63, wid = tidx() >> 6;
    unsigned char* ltab = (unsigned char*)smem + 36864 + wid * 2048 + lane * 32;
    const bf16_t* keys = pp->PKEYS + (size_t)layer * 8 * 2 * 128 * 64;
    route_unit(*pp, keys, n0 >> 7, m0 + 32 * wid, (const bf16_t*)smem + (32 * wid + (lane & 31)) * RQ_STRIDE, ltab);
  }
};

template <class Epi, int KD>
__device__ __forceinline__ void gemm_epi_dispatch(const Epi& epi, int kd, f32x4 (&acc)[4][4], int tbase, int nb64, int q) {
  if (kd == KD) {
#pragma unroll
    for (int tb = 0; tb < 4; tb++) {
      const int t = tbase + tb * 16;
      float v0[8], v1[8];
      v0[0] = acc[tb][0][0]; v0[1] = acc[tb][0][1]; v0[2] = acc[tb][0][2]; v0[3] = acc[tb][0][3];
      v0[4] = acc[tb][1][0]; v0[5] = acc[tb][1][1]; v0[6] = acc[tb][1][2]; v0[7] = acc[tb][1][3];
      v1[0] = acc[tb][2][0]; v1[1] = acc[tb][2][1]; v1[2] = acc[tb][2][2]; v1[3] = acc[tb][2][3];
      v1[4] = acc[tb][3][0]; v1[5] = acc[tb][3][1]; v1[6] = acc[tb][3][2]; v1[7] = acc[tb][3][3];
      epi.template tok<KD>(t, nb64, q, v0, v1);
    }
  } else if constexpr (KD + 1 < Epi::NK) {
    gemm_epi_dispatch<Epi, KD + 1>(epi, kd, acc, tbase, nb64, q);
  }
}

__device__ __forceinline__ void glds16(const void* g, unsigned lds_base) {
  unsigned sv;
  asm volatile("s_mov_b32 %0, m0\n\ts_mov_b32 m0, %2\n\ts_nop 0\n\tglobal_load_lds_dwordx4 %1, off\n\ts_mov_b32 m0, %0"
               : "=&s"(sv)
               : "v"(g), "s"(lds_base)
               : "memory");
}

template <class T, class = void>
struct epi_has_hook { static constexpr bool value = false; };
template <class T>
struct epi_has_hook<T, decltype((void)T::TILE_HOOK)> { static constexpr bool value = true; };

template <class Epi>
__device__ __forceinline__ void gemm_mfma(const bf16_t* __restrict__ A, int lda, const bf16_t* __restrict__ W, int ldw, int M, int N, int K,
                          const Epi& epi, char* smem, int bid, int nb) {
  const int tid = tidx(), lane = tid & 63, wid = tid >> 6;
  const int wm = wid >> 1, wn = wid & 1;
  const int l15 = lane & 15, q = lane >> 4;
  const int srow0 = tid >> 3, sc = tid & 7;
  const int tilesN = N / 128, tiles = (M / 128) * tilesN, nk = K / 64;
  const int lrow = srow0, lpos = sc;
  const int wperm = (((lrow >> 2) & 3) << 3) | (((lrow >> 4) & 1) << 2) | (lrow & 3);
  const size_t aoff = (size_t)lrow * lda + ((lpos ^ (lrow & 7)) << 3);
  const size_t woff = (size_t)wperm * ldw + ((lpos ^ (lrow & 7)) << 3);
  const int wbase = __builtin_amdgcn_readfirstlane(wid) * 1024;
  const unsigned ldsb = (unsigned)(uintptr_t)smem;
#define STAGE(buf, AP, WP, kk)                                                                      \
  {                                                                                                 \
    const unsigned da_ = (unsigned)__builtin_amdgcn_readfirstlane((int)(ldsb + (buf) * 16384 + wbase));         \
    const unsigned db_ = da_ + 32768;                                                               \
    glds16((AP) + (kk), da_);                                                                       \
    glds16((AP) + (size_t)32 * lda + (kk), da_ + 4096);                                             \
    glds16((AP) + (size_t)64 * lda + (kk), da_ + 8192);                                             \
    glds16((AP) + (size_t)96 * lda + (kk), da_ + 12288);                                            \
    glds16((WP) + (kk), db_);                                                                       \
    glds16((WP) + (size_t)32 * ldw + (kk), db_ + 4096);                                             \
    glds16((WP) + (size_t)64 * ldw + (kk), db_ + 8192);                                             \
    glds16((WP) + (size_t)96 * ldw + (kk), db_ + 12288);                                            \
  }
  constexpr bool PREF = !epi_has_hook<Epi>::value;
  bool staged = false;
  for (int tile = bid; tile < tiles; tile += nb) {
    const int m0 = (tile / tilesN) * 128, n0 = (tile % tilesN) * 128;
    f32x4 acc[4][4];
#pragma unroll
    for (int i = 0; i < 4; i++)
#pragma unroll
      for (int j = 0; j < 4; j++) acc[i][j] = (f32x4){0.f, 0.f, 0.f, 0.f};
    const bf16_t* Ag = A + (size_t)m0 * lda + aoff;
    const bf16_t* Wg = W + (size_t)n0 * ldw + woff;
    const int tile2 = tile + nb;
    const bool has2 = PREF && tile2 < tiles;
    const bf16_t* Ag2 = A + (size_t)((has2 ? tile2 : tile) / tilesN) * 128 * lda + aoff;
    const bf16_t* Wg2 = W + (size_t)((has2 ? tile2 : tile) % tilesN) * 128 * ldw + woff;
    if (!staged) {
      __syncthreads();
      STAGE(0, Ag, Wg, 0);
    }
    asm volatile("s_waitcnt vmcnt(0) lgkmcnt(0)\n\ts_barrier" ::: "memory");
    for (int kt = 0; kt < nk; kt++) {
      const int cur = kt & 1;
      if (kt + 1 < nk) { STAGE(cur ^ 1, Ag, Wg, (kt + 1) * 64); }
      else if (has2) { STAGE(0, Ag2, Wg2, 0); }
      const char* sA = smem + cur * 16384;
      const char* sB = smem + 32768 + cur * 16384;
#pragma unroll
      for (int s = 0; s < 2; s++) {
        const int c = 4 * s + q;
        const int xr = wm * 64 + l15, wr = wn * 64 + l15;
        const char* xa = sA + xr * 128 + ((c ^ (xr & 7)) << 4);
        const char* wa = sB + wr * 128 + ((c ^ (wr & 7)) << 4);
        const bf16x8 xf0 = *(const bf16x8*)(xa), xf1 = *(const bf16x8*)(xa + 2048), xf2 = *(const bf16x8*)(xa + 4096),
                     xf3 = *(const bf16x8*)(xa + 6144);
        const bf16x8 wf0 = *(const bf16x8*)(wa), wf1 = *(const bf16x8*)(wa + 2048), wf2 = *(const bf16x8*)(wa + 4096),
                     wf3 = *(const bf16x8*)(wa + 6144);
#define MM(tb, fb, xf, wf) acc[tb][fb] = __builtin_amdgcn_mfma_f32_16x16x32_bf16(wf, xf, acc[tb][fb], 0, 0, 0)
        MM(0, 0, xf0, wf0); MM(0, 1, xf0, wf1); MM(0, 2, xf0, wf2); MM(0, 3, xf0, wf3);
        MM(1, 0, xf1, wf0); MM(1, 1, xf1, wf1); MM(1, 2, xf1, wf2); MM(1, 3, xf1, wf3);
        MM(2, 0, xf2, wf0); MM(2, 1, xf2, wf1); MM(2, 2, xf2, wf2); MM(2, 3, xf2, wf3);
        MM(3, 0, xf3, wf0); MM(3, 1, xf3, wf1); MM(3, 2, xf3, wf2); MM(3, 3, xf3, wf3);
#undef MM
      }
      if (kt + 1 < nk) asm volatile("s_waitcnt vmcnt(0) lgkmcnt(0)\n\ts_barrier" ::: "memory");
      else asm volatile("s_waitcnt lgkmcnt(0)\n\ts_barrier" ::: "memory");
    }
    staged = has2;
    gemm_epi_dispatch<Epi, 0>(epi, epi.kind(n0 + wn * 64), acc, m0 + wm * 64 + l15, n0 + wn * 64, q);
    if constexpr (epi_has_hook<Epi>::value) epi.tile_hook(m0, n0);
  }
#undef STAGE
}


__device__ __forceinline__ float ret_log2g(int h);
__device__ __forceinline__ void moba_kmean(const Params& p, int bid, int nb) {
  for (int idx = bid * NTHREADS + tidx(); idx < 8 * 64 * 64; idx += nb * NTHREADS) {
    const int d = idx & 63, blk = (idx >> 6) & 63, h = idx >> 12;
    float s = 0.f;
    for (int j = 0; j < 256; j++) s += bf2f(p.MK[(size_t)(blk * 256 + j) * 512 + h * 64 + d]);
    p.KMEAN[idx] = s * (1.f / 256.f);
  }
}

__device__ __forceinline__ void moba_select(const Params& p, char* smem, int bid, int nb) {
  const int tid = tidx();
  int* lcnt = (int*)smem;
  int* lbase = (int*)smem + 64;
  for (int it = bid; it < 8 * 64; it += nb) {
    const int h = it >> 6, blk = it & 63;
    const int t = blk * 256 + tid;
    float q[64];
    const uint4* qp = (const uint4*)(p.MQ + (size_t)t * 512 + h * 64);
#pragma unroll
    for (int c = 0; c < 8; c++) {
      const uint4 u = qp[c];
      q[c * 8 + 0] = __uint_as_float(u.x << 16); q[c * 8 + 1] = __uint_as_float(u.x & 0xffff0000u);
      q[c * 8 + 2] = __uint_as_float(u.y << 16); q[c * 8 + 3] = __uint_as_float(u.y & 0xffff0000u);
      q[c * 8 + 4] = __uint_as_float(u.z << 16); q[c * 8 + 5] = __uint_as_float(u.z & 0xffff0000u);
      q[c * 8 + 6] = __uint_as_float(u.w << 16); q[c * 8 + 7] = __uint_as_float(u.w & 0xffff0000u);
    }
    float v1 = -INFINITY, v2 = -INFINITY, v3 = -INFINITY;
    int i1 = -1, i2 = -1, i3 = -1;
    for (int j = 0; j < blk; j++) {
      const float* km = p.KMEAN + ((size_t)h * 64 + j) * 64;
      float g = 0.f;
#pragma unroll
      for (int d = 0; d < 64; d++) g += q[d] * km[d];
      if (g > v1) { v3 = v2; i3 = i2; v2 = v1; i2 = i1; v1 = g; i1 = j; }
      else if (g > v2) { v3 = v2; i3 = i2; v2 = g; i2 = j; }
      else if (g > v3) { v3 = g; i3 = j; }
    }
    if (tid < 64) lcnt[tid] = 0;
    __syncthreads();
    int p1 = 0, p2 = 0, p3 = 0;
    if (i1 >= 0) p1 = atomicAdd(&lcnt[i1], 1);
    if (i2 >= 0) p2 = atomicAdd(&lcnt[i2], 1);
    if (i3 >= 0) p3 = atomicAdd(&lcnt[i3], 1);
    __syncthreads();
    if (tid < 64) {
      const int c = lcnt[tid];
      if (c > 0) lbase[tid] = (int)atomicAdd(&p.GCNT[h * 64 + tid], (unsigned)c);
    }
    __syncthreads();
    if (i1 >= 0) p.MLIST[(size_t)(h * 64 + i1) * MOBA_LSTRIDE + lbase[i1] + p1] = ((unsigned)t << 2) | 0u;
    if (i2 >= 0) p.MLIST[(size_t)(h * 64 + i2) * MOBA_LSTRIDE + lbase[i2] + p2] = ((unsigned)t << 2) | 1u;
    if (i3 >= 0) p.MLIST[(size_t)(h * 64 + i3) * MOBA_LSTRIDE + lbase[i3] + p3] = ((unsigned)t << 2) | 2u;
    __syncthreads();
  }
}

template <int DQ, bool CAUSAL>
__device__ __forceinline__ void attn_tile(const char* kb, const char* vb, const bf16x8 (&qf)[DQ / 16], f32x16& o0, f32x16& o1,
                                          float& m, float& lsum, int j, bool first, int q0, int qg, int hi,
                                          const int (&koff)[DQ / 16], const int (&voff)[4]) {
  constexpr int KS = DQ / 16;
  const bool active = CAUSAL ? (j * 64 <= q0 + 31) : true;
  if (active) {
    f32x16 s0, s1;
    const float negm = -m;
#pragma unroll
    for (int r = 0; r < 16; r++) { s0[r] = negm; s1[r] = negm; }
#pragma unroll
    for (int s = 0; s < KS; s++) {
      const bf16x8 k0 = *(const bf16x8*)(kb + koff[s]);
      const bf16x8 k1 = *(const bf16x8*)(kb + koff[s] + 32 * (DQ * 2));
      s0 = __builtin_amdgcn_mfma_f32_32x32x16_bf16(k0, qf[s], s0, 0, 0, 0);
      s1 = __builtin_amdgcn_mfma_f32_32x32x16_bf16(k1, qf[s], s1, 0, 0, 0);
    }
    if (CAUSAL && (j * 64 + 63 > q0)) {
      const int kv0 = j * 64 + 8 * hi;
#pragma unroll
      for (int r = 0; r < 16; r++) {
        const int kva = kv0 + 16 * (r >> 3) + (r & 7);
        s0[r] = (kva <= qg) ? s0[r] : -INFINITY;
        s1[r] = (kva + 32 <= qg) ? s1[r] : -INFINITY;
      }
    }
    float mx = s0[0];
#pragma unroll
    for (int r = 1; r < 16; r++) mx = fmaxf(mx, s0[r]);
#pragma unroll
    for (int r = 0; r < 16; r++) mx = fmaxf(mx, s1[r]);
    {
      typedef __attribute__((ext_vector_type(2))) unsigned u32x2_t;
      const u32x2_t sw = __builtin_amdgcn_permlane32_swap(__float_as_uint(mx), __float_as_uint(mx), false, false);
      mx = fmaxf(__uint_as_float(sw[0]), __uint_as_float(sw[1]));
    }
    if (first || __any(mx > ATT_THR)) {
      const float d = first ? mx : ((mx > ATT_THR) ? mx : 0.f);
      const float alpha = __builtin_amdgcn_exp2f(-d);
      m += d;
      lsum *= alpha;
#pragma unroll
      for (int r = 0; r < 16; r++) {
        o0[r] *= alpha; o1[r] *= alpha;
        s0[r] -= d; s1[r] -= d;
      }
    }
    float ps = 0.f;
#pragma unroll
    for (int r = 0; r < 16; r++) {
      s0[r] = __builtin_amdgcn_exp2f(s0[r]);
      s1[r] = __builtin_amdgcn_exp2f(s1[r]);
      ps += s0[r] + s1[r];
    }
    lsum += ps;
    bf16x8 pb[4];
    {
      typedef __attribute__((ext_vector_type(4))) unsigned u32x4;
      u32x4 t0, t1, t2, t3;
      t0[0] = pack2(s0[0], s0[1]); t0[1] = pack2(s0[2], s0[3]); t0[2] = pack2(s0[4], s0[5]); t0[3] = pack2(s0[6], s0[7]);
      t1[0] = pack2(s0[8], s0[9]); t1[1] = pack2(s0[10], s0[11]); t1[2] = pack2(s0[12], s0[13]); t1[3] = pack2(s0[14], s0[15]);
      t2[0] = pack2(s1[0], s1[1]); t2[1] = pack2(s1[2], s1[3]); t2[2] = pack2(s1[4], s1[5]); t2[3] = pack2(s1[6], s1[7]);
      t3[0] = pack2(s1[8], s1[9]); t3[1] = pack2(s1[10], s1[11]); t3[2] = pack2(s1[12], s1[13]); t3[3] = pack2(s1[14], s1[15]);
      pb[0] = __builtin_bit_cast(bf16x8, t0);
      pb[1] = __builtin_bit_cast(bf16x8, t1);
      pb[2] = __builtin_bit_cast(bf16x8, t2);
      pb[3] = __builtin_bit_cast(bf16x8, t3);
    }
#pragma unroll
    for (int ks = 0; ks < 4; ks++) {
      const bf16x8 v0 = *(const bf16x8*)(vb + voff[ks]);
      const bf16x8 v1 = *(const bf16x8*)(vb + voff[ks] + 32 * 128);
      o0 = __builtin_amdgcn_mfma_f32_32x32x16_bf16(v0, pb[ks], o0, 0, 0, 0);
      o1 = __builtin_amdgcn_mfma_f32_32x32x16_bf16(v1, pb[ks], o1, 0, 0, 0);
    }
  }
}

#define PINV(x) asm volatile("" : "+v"(x))
#define ATT_PTHR 256.f
template <int DQ, bool MASK>
__device__ __forceinline__ void attn_tile3(const char* kb, const char* vb, const bf16x8 (&qf)[DQ / 16], f32x16& o0, f32x16& o1,
                                           float& m, float& lsum, f32x16& negm, int j, int qg, int hi,
                                           const int (&koff)[DQ / 16], const int (&voff)[4]) {
  constexpr int KS = DQ / 16;
  f32x16 s0, s1;
#pragma unroll
  for (int s = 0; s < KS; s++) {
    const bf16x8 k0 = *(const bf16x8*)(kb + koff[s]);
    const bf16x8 k1 = *(const bf16x8*)(kb + koff[s] + 32 * (DQ * 2));
    if (s == 0) {
      s0 = __builtin_amdgcn_mfma_f32_32x32x16_bf16(k0, qf[0], negm, 0, 0, 0);
      s1 = __builtin_amdgcn_mfma_f32_32x32x16_bf16(k1, qf[0], negm, 0, 0, 0);
    } else {
      s0 = __builtin_amdgcn_mfma_f32_32x32x16_bf16(k0, qf[s], s0, 0, 0, 0);
      s1 = __builtin_amdgcn_mfma_f32_32x32x16_bf16(k1, qf[s], s1, 0, 0, 0);
    }
  }
  if (MASK) {
    const int kv0 = j * 64 + 8 * hi;
#pragma unroll
    for (int r = 0; r < 16; r++) {
      const int kva = kv0 + 16 * (r >> 3) + (r & 7);
      s0[r] = (kva <= qg) ? s0[r] : -INFINITY;
      s1[r] = (kva + 32 <= qg) ? s1[r] : -INFINITY;
    }
  }
  float psA = 0.f, psB = 0.f;
#pragma unroll
  for (int r = 0; r < 16; r++) {
    s0[r] = __builtin_amdgcn_exp2f(s0[r]);
    s1[r] = __builtin_amdgcn_exp2f(s1[r]);
  }
#pragma unroll
  for (int r = 0; r < 16; r++) { psA += s0[r]; psB += s1[r]; }
  bf16x8 pb[4];
  {
    typedef __attribute__((ext_vector_type(4))) unsigned u32x4;
    u32x4 t0, t1, t2, t3;
    t0[0] = pack2(s0[0], s0[1]); t0[1] = pack2(s0[2], s0[3]); t0[2] = pack2(s0[4], s0[5]); t0[3] = pack2(s0[6], s0[7]);
    t1[0] = pack2(s0[8], s0[9]); t1[1] = pack2(s0[10], s0[11]); t1[2] = pack2(s0[12], s0[13]); t1[3] = pack2(s0[14], s0[15]);
    t2[0] = pack2(s1[0], s1[1]); t2[1] = pack2(s1[2], s1[3]); t2[2] = pack2(s1[4], s1[5]); t2[3] = pack2(s1[6], s1[7]);
    t3[0] = pack2(s1[8], s1[9]); t3[1] = pack2(s1[10], s1[11]); t3[2] = pack2(s1[12], s1[13]); t3[3] = pack2(s1[14], s1[15]);
    pb[0] = __builtin_bit_cast(bf16x8, t0);
    pb[1] = __builtin_bit_cast(bf16x8, t1);
    pb[2] = __builtin_bit_cast(bf16x8, t2);
    pb[3] = __builtin_bit_cast(bf16x8, t3);
  }
#pragma unroll
  for (int ks = 0; ks < 4; ks++) {
    const bf16x8 v0 = *(const bf16x8*)(vb + voff[ks]);
    const bf16x8 v1 = *(const bf16x8*)(vb + voff[ks] + 32 * 128);
    o0 = __builtin_amdgcn_mfma_f32_32x32x16_bf16(v0, pb[ks], o0, 0, 0, 0);
    o1 = __builtin_amdgcn_mfma_f32_32x32x16_bf16(v1, pb[ks], o1, 0, 0, 0);
  }
  const float ps = psA + psB;
  lsum += ps;
  float pt;
  {
    typedef __attribute__((ext_vector_type(2))) unsigned u32x2_t;
    const u32x2_t sw = __builtin_amdgcn_permlane32_swap(__float_as_uint(ps), __float_as_uint(ps), false, false);
    pt = __uint_as_float(sw[0]) + __uint_as_float(sw[1]);
  }
  if (__any(pt > ATT_PTHR)) {
    const float d = (pt > ATT_PTHR) ? __log2f(pt) : 0.f;
    const float alpha = __builtin_amdgcn_exp2f(-d);
    m += d;
    lsum *= alpha;
    const float nm = -m;
#pragma unroll
    for (int r = 0; r < 16; r++) { o0[r] *= alpha; o1[r] *= alpha; negm[r] = nm; }
    PINV(negm);
  }
}

template <int CPR>
__device__ __forceinline__ int attn_swz(int c, int row) {
  if constexpr (CPR == 12) return (c & ~3) | ((c & 3) ^ ((row >> 2) & 3));
  else return c ^ ((row >> 1) & 7);
}
template <int DQ, bool CAUSAL>
__device__ __forceinline__ void attn_core(const bf16_t* __restrict__ Q, const bf16_t* __restrict__ Kp,
                                          const bf16_t* __restrict__ VT, int H, int h, int qg, int q0, int jlo, int jhi,
                                          char* smem, f32x16& o0, f32x16& o1, float& m, float& lsum) {
  constexpr int KS = DQ / 16;
  constexpr int CPR = DQ / 8;
  constexpr int KPW = CPR / 4;
  constexpr int KBYTES = CPR * 1024;
  constexpr int SLOT = KBYTES + 8192;
  static_assert(3 * SLOT <= 61440, "attention ring");
  const int tid = tidx(), lane = tid & 63;
  const int wid = __builtin_amdgcn_readfirstlane(tid >> 6);
  const int l31 = lane & 31, hi = lane >> 5;
  const int ldq = H * DQ;
  const int sig = (l31 & 19) | ((l31 & 4) << 1) | ((l31 & 8) >> 1);
  const unsigned lds0 = (unsigned)(uintptr_t)smem;
  int koff[KS], voff[4];
#pragma unroll
  for (int s = 0; s < KS; s++) koff[s] = sig * (DQ * 2) + attn_swz<CPR>(2 * s + hi, sig) * 16;
#pragma unroll
  for (int ks = 0; ks < 4; ks++) voff[ks] = l31 * 128 + attn_swz<8>(2 * ks + hi, l31) * 16;
  const bf16_t* kg0; const bf16_t* kg1; const bf16_t* kg2; const bf16_t* vg0; const bf16_t* vg1;
  {
    const int id0 = wid * 64 + lane, id1 = id0 + 256, id2 = id0 + 512;
    const int r0 = id0 / CPR, r1 = id1 / CPR, r2 = id2 / CPR;
    kg0 = Kp + (size_t)r0 * ldq + h * DQ + attn_swz<CPR>(id0 % CPR, r0) * 8;
    kg1 = Kp + (size_t)r1 * ldq + h * DQ + attn_swz<CPR>(id1 % CPR, r1) * 8;
    kg2 = Kp + (size_t)r2 * ldq + h * DQ + attn_swz<CPR>(id2 % CPR, r2) * 8;
    const int vr0 = id0 >> 3, vr1 = id1 >> 3;
    vg0 = VT + ((size_t)h * 64 + vr0) * T_ + attn_swz<8>(id0 & 7, vr0) * 8;
    vg1 = VT + ((size_t)h * 64 + vr1) * T_ + attn_swz<8>(id1 & 7, vr1) * 8;
  }
#define DMA_TILE(j, slotoff)                                                                                         \
  {                                                                                                                  \
    const size_t ko_ = (size_t)(j) * 64 * ldq;                                                                       \
    const unsigned kd_ = (unsigned)__builtin_amdgcn_readfirstlane((int)(lds0 + (slotoff) + wid * 1024));            \
    glds16(kg0 + ko_, kd_);                                                                                          \
    glds16(kg1 + ko_, kd_ + 4096);                                                                                   \
    if constexpr (KPW > 2) glds16(kg2 + ko_, kd_ + 8192);                                                            \
    glds16(vg0 + (j) * 64, kd_ + KBYTES);                                                                            \
    glds16(vg1 + (j) * 64, kd_ + KBYTES + 4096);                                                                     \
  }
#define WAIT_BAR_NP() { if constexpr (KPW > 2) asm volatile("s_waitcnt vmcnt(5) lgkmcnt(0)\n\ts_barrier" ::: "memory"); \
                        else asm volatile("s_waitcnt vmcnt(4) lgkmcnt(0)\n\ts_barrier" ::: "memory"); }
#define WAIT_BAR_0() asm volatile("s_waitcnt vmcnt(0) lgkmcnt(0)\n\ts_barrier" ::: "memory")
  bf16x8 qf[KS];
#pragma unroll
  for (int s = 0; s < KS; s++) qf[s] = *(const bf16x8*)(Q + (size_t)qg * ldq + h * DQ + 16 * s + 8 * hi);
#pragma unroll
  for (int s = 0; s < KS; s++) PINV(qf[s]);
#pragma unroll
  for (int r = 0; r < 16; r++) { o0[r] = 0.f; o1[r] = 0.f; }
  m = 0.f;
  lsum = 0.f;
  f32x16 negm;
#pragma unroll
  for (int r = 0; r < 16; r++) negm[r] = 0.f;
  __syncthreads();
  DMA_TILE(jlo, 0);
  if (jlo + 1 <= jhi) { DMA_TILE(jlo + 1, SLOT); WAIT_BAR_NP(); } else { WAIT_BAR_0(); }
  int j = jlo;
  int s_cur = 0, s_n1 = SLOT, s_n2 = 2 * SLOT;
  if (j + 2 <= jhi) DMA_TILE(j + 2, s_n2);
  attn_tile<DQ, CAUSAL>(smem + s_cur, smem + s_cur + KBYTES, qf, o0, o1, m, lsum, j, true, q0, qg, hi, koff, voff);
  {
    const float nm = -m;
#pragma unroll
    for (int r = 0; r < 16; r++) negm[r] = nm;
    PINV(negm);
  }
  if (j + 2 <= jhi) { WAIT_BAR_NP(); } else { WAIT_BAR_0(); }
  ++j;
  while (j <= jhi) {
    { const int t_ = s_cur; s_cur = s_n1; s_n1 = s_n2; s_n2 = t_; }
    if (j + 2 <= jhi) DMA_TILE(j + 2, s_n2);
    if (CAUSAL && (j * 64 + 63 > q0)) attn_tile3<DQ, true>(smem + s_cur, smem + s_cur + KBYTES, qf, o0, o1, m, lsum, negm, j, qg, hi, koff, voff);
    else attn_tile3<DQ, false>(smem + s_cur, smem + s_cur + KBYTES, qf, o0, o1, m, lsum, negm, j, qg, hi, koff, voff);
    if (j + 2 <= jhi) { WAIT_BAR_NP(); } else { WAIT_BAR_0(); }
    ++j;
  }
#undef DMA_TILE
#undef WAIT_BAR_NP
#undef WAIT_BAR_0
}

__device__ __forceinline__ void attn_store_rows(bf16_t* op, const f32x16& o0, const f32x16& o1, float inv) {
#pragma unroll
  for (int rg = 0; rg < 4; rg++) {
    uint2 w0, w1;
    w0.x = pack2(o0[4 * rg] * inv, o0[4 * rg + 1] * inv);
    w0.y = pack2(o0[4 * rg + 2] * inv, o0[4 * rg + 3] * inv);
    w1.x = pack2(o1[4 * rg] * inv, o1[4 * rg + 1] * inv);
    w1.y = pack2(o1[4 * rg + 2] * inv, o1[4 * rg + 3] * inv);
    *(uint2*)(op + 8 * rg) = w0;
    *(uint2*)(op + 32 + 8 * rg) = w1;
  }
}

template <int DQ>
__device__ __forceinline__ void attn_causal(const bf16_t* __restrict__ Q, const bf16_t* __restrict__ Kp,
                                            const bf16_t* __restrict__ VT, bf16_t* __restrict__ O, int ldo, int H, char* smem,
                                            int bid, int nb) {
  const int lane = tidx() & 63, wid = tidx() >> 6;
  const int l31 = lane & 31, hi = lane >> 5;
  const int xcd = bid & 7, local = bid >> 3, nloc = nb >> 3;
  for (int idx = local; idx < 64 * (H >> 3); idx += nloc) {
    const int h = xcd + 8 * (idx >> 6), pi = idx & 63;
    for (int half = 0; half < 2; half++) {
      const int qt = half ? (127 - pi) : pi;
      const int q0 = qt * 128 + wid * 32;
      const int qg = q0 + l31;
      f32x16 o0, o1;
      float m, lsum;
      attn_core<DQ, true>(Q, Kp, VT, H, h, qg, q0, 0, 2 * qt + 1, smem, o0, o1, m, lsum);
      const float ltot = lsum + __shfl_xor(lsum, 32);
      attn_store_rows(O + (size_t)qg * ldo + h * 64 + 4 * hi, o0, o1, 1.f / ltot);
    }
  }
}

__device__ __forceinline__ void moba_gathered(const Params& p, char* smem, int bid, int nb) {
  const int tid = tidx(), lane = tid & 63, wid = tid >> 6;
  const int l31 = lane & 31, hi = lane >> 5;
  int* pre = (int*)(smem + 49152);
  {
    const int c0 = (int)((p.GCNT[2 * tid] + 127u) >> 7), c1 = (int)((p.GCNT[2 * tid + 1] + 127u) >> 7);
    int sc = c0 + c1;
#pragma unroll
    for (int o = 1; o < 64; o <<= 1) {
      const int v = __shfl_up(sc, o);
      if (lane >= o) sc += v;
    }
    int* wsum = pre + 520;
    if (lane == 63) wsum[wid] = sc;
    __syncthreads();
    int off = 0;
    for (int w = 0; w < wid; w++) off += wsum[w];
    const int incl = sc + off;
    pre[2 * tid] = incl - c0 - c1;
    pre[2 * tid + 1] = incl - c1;
    if (tid == 255) pre[512] = incl;
    __syncthreads();
  }
  const int total = pre[512];
  for (int c = bid; c < total; c += nb) {
    int lo = 0, hi_ = 512;
    while (hi_ - lo > 1) {
      const int mid = (lo + hi_) >> 1;
      if (pre[mid] <= c) lo = mid; else hi_ = mid;
    }
    const int k = __builtin_amdgcn_readfirstlane(lo);
    const int h = k >> 6, jb = k & 63;
    const int cnt = (int)p.GCNT[k];
    const int e = (c - pre[k]) * 128 + wid * 32 + l31;
    const bool valid = e < cnt;
    const unsigned ent = p.MLIST[(size_t)k * MOBA_LSTRIDE + (valid ? e : 0)];
    const int tq = (int)(ent >> 2), r = (int)(ent & 3u);
    f32x16 o0, o1;
    float m, lsum;
    attn_core<64, false>(p.MQ, p.MK, p.MVT, 8, h, tq, 0, 4 * jb, 4 * jb + 3, smem, o0, o1, m, lsum);
    const float ltot = lsum + __shfl_xor(lsum, 32);
    if (valid) {
      const size_t slot = ((size_t)tq * 8 + h) * 3 + r;
      attn_store_rows(p.PO + slot * 64 + 4 * hi, o0, o1, 1.f / ltot);
      if (hi == 0) *(float2*)(p.PML + slot * 2) = make_float2(m, ltot);
    }
  }
}

__device__ __forceinline__ void moba_own_merge(const Params& p, char* smem, int bid, int nb) {
  const int lane = tidx() & 63, wid = tidx() >> 6;
  const int l31 = lane & 31, hi = lane >> 5;
  const int xcd = bid & 7, local = bid >> 3, nloc = nb >> 3;
  for (int idx = local; idx < 64; idx += nloc) {
    const int h = xcd, pi = idx & 63;
    for (int half = 0; half < 2; half++) {
      const int qt = half ? (127 - pi) : pi;
      const int q0 = qt * 128 + wid * 32;
      const int qg = q0 + l31;
      const int blk = qt >> 1;
      f32x16 o0, o1;
      float m, lsum;
      attn_core<64, true>(p.MQ, p.MK, p.MVT, 8, h, qg, q0, 4 * blk, 2 * qt + 1, smem, o0, o1, m, lsum);
      float l = lsum + __shfl_xor(lsum, 32);
      const int nsel = blk < 3 ? blk : 3;
      const size_t slot0 = ((size_t)qg * 8 + h) * 3;
      float2 st0 = *(const float2*)(p.PML + (slot0 + 0) * 2), st1 = *(const float2*)(p.PML + (slot0 + 1) * 2),
             st2 = *(const float2*)(p.PML + (slot0 + 2) * 2);
      uint2 pa[3][4], pq[3][4];
#pragma unroll
      for (int rr = 0; rr < 3; rr++) {
        const bf16_t* pp = p.PO + (slot0 + rr) * 64 + 4 * hi;
#pragma unroll
        for (int rg = 0; rg < 4; rg++) { pa[rr][rg] = *(const uint2*)(pp + 8 * rg); pq[rr][rg] = *(const uint2*)(pp + 32 + 8 * rg); }
      }
      const float pm0 = nsel > 0 ? st0.x : -1e30f, pl0 = nsel > 0 ? st0.y : 0.f;
      const float pm1 = nsel > 1 ? st1.x : -1e30f, pl1 = nsel > 1 ? st1.y : 0.f;
      const float pm2 = nsel > 2 ? st2.x : -1e30f, pl2 = nsel > 2 ? st2.y : 0.f;
      const float M = fmaxf(fmaxf(m, pm0), fmaxf(pm1, pm2));
      const float w = __builtin_amdgcn_exp2f(m - M);
      const float w0 = pl0 * __builtin_amdgcn_exp2f(pm0 - M), w1 = pl1 * __builtin_amdgcn_exp2f(pm1 - M),
                  w2 = pl2 * __builtin_amdgcn_exp2f(pm2 - M);
      const float L = l * w + w0 + w1 + w2;
#pragma unroll
      for (int r = 0; r < 16; r++) { o0[r] *= w; o1[r] *= w; }
#pragma unroll
      for (int rr = 0; rr < 3; rr++) {
        const float wr = rr == 0 ? w0 : (rr == 1 ? w1 : w2);
        const unsigned vm = (unsigned)-(int)(rr < nsel);
#pragma unroll
        for (int rg = 0; rg < 4; rg++) {
          const unsigned ax = pa[rr][rg].x & vm, ay = pa[rr][rg].y & vm, bx = pq[rr][rg].x & vm, by = pq[rr][rg].y & vm;
          o0[4 * rg] += wr * __uint_as_float(ax << 16); o0[4 * rg + 1] += wr * __uint_as_float(ax & 0xffff0000u);
          o0[4 * rg + 2] += wr * __uint_as_float(ay << 16); o0[4 * rg + 3] += wr * __uint_as_float(ay & 0xffff0000u);
          o1[4 * rg] += wr * __uint_as_float(bx << 16); o1[4 * rg + 1] += wr * __uint_as_float(bx & 0xffff0000u);
          o1[4 * rg + 2] += wr * __uint_as_float(by << 16); o1[4 * rg + 3] += wr * __uint_as_float(by & 0xffff0000u);
        }
      }
      attn_store_rows(p.CAT + (size_t)qg * 1536 + h * 64 + 4 * hi, o0, o1, 1.f / L);
    }
  }
}

__device__ __forceinline__ float ret_log2g(int h) { return log2f(1.f - exp2f(-5.f - (float)h)); }

__device__ __forceinline__ void retention_state(const Params& p, int bid, int nb) {
  const int lane = tidx() & 63, wid = tidx() >> 6;
  const int l31 = lane & 31, hi = lane >> 5;
  for (int it = bid * 4 + wid; it < 8 * 128 * 4; it += nb * 4) {
    const int eb = it & 3, i = (it >> 2) & 127, h = it >> 9;
    const bf16_t* kt = p.RKTZ + ((size_t)h * 64 + l31) * T_ + i * 128 + 8 * hi;
    const bf16_t* vt = p.RVT + ((size_t)h * 128 + eb * 32 + l31) * T_ + i * 128 + 8 * hi;
    f32x16 a0, a1;
#pragma unroll
    for (int r = 0; r < 16; r++) { a0[r] = 0.f; a1[r] = 0.f; }
#pragma unroll
    for (int s = 0; s < 8; s++) {
      const bf16x8 k0 = *(const bf16x8*)(kt + 16 * s);
      const bf16x8 k1 = *(const bf16x8*)(kt + (size_t)32 * T_ + 16 * s);
      const bf16x8 vf = *(const bf16x8*)(vt + 16 * s);
      a0 = __builtin_amdgcn_mfma_f32_32x32x16_bf16(k0, vf, a0, 0, 0, 0);
      a1 = __builtin_amdgcn_mfma_f32_32x32x16_bf16(k1, vf, a1, 0, 0, 0);
    }
    float* sp = p.SST + (((size_t)h * 128 + i) * 128 + eb * 32 + l31) * 64 + 4 * hi;
#pragma unroll
    for (int rg = 0; rg < 4; rg++) {
      *(float4*)(sp + 8 * rg) = make_float4(a0[4 * rg], a0[4 * rg + 1], a0[4 * rg + 2], a0[4 * rg + 3]);
      *(float4*)(sp + 32 + 8 * rg) = make_float4(a1[4 * rg], a1[4 * rg + 1], a1[4 * rg + 2], a1[4 * rg + 3]);
    }
  }
}

__device__ __forceinline__ void retention_prefix(const Params& p, int bid, int nb) {
  for (int idx = bid * NTHREADS + tidx(); idx < 8 * 128 * 64; idx += nb * NTHREADS) {
    const int h = idx >> 13, ed = idx & 8191;
    const float g128 = exp2f(128.f * ret_log2g(h));
    float R = 0.f;
    const float* sp = p.SST + (size_t)h * 128 * 8192 + ed;
    bf16_t* rp = p.RT + (size_t)h * 128 * 8192 + ed;
#pragma unroll 8
    for (int i = 0; i < 128; i++) {
      rp[(size_t)i * 8192] = f2bf(R);
      R = g128 * R + sp[(size_t)i * 8192];
    }
  }
}

__device__ __forceinline__ void retention_out(const Params& p, char* smem, int bid, int nb) {
  constexpr int KSTR = 144, VSTR = 272, KBYTES = 128 * KSTR;
  const int tid = tidx(), lane = tid & 63, w = tid >> 6;
  const int l31 = lane & 31, hi = lane >> 5;
  const int sig = (l31 & 19) | ((l31 & 4) << 1) | ((l31 & 8) >> 1);
  char* sK = smem;
  char* sV = smem + KBYTES;
  for (int it = bid; it < 8 * 128; it += nb) {
    const int i = it & 127, h = it >> 7;
    const int t0 = i * 128;
    const int nl = 32 * w + l31;
    const float lg = ret_log2g(h);
    bf16x8 qf[4];
#pragma unroll
    for (int s = 0; s < 4; s++) qf[s] = *(const bf16x8*)(p.RQ + (size_t)(t0 + nl) * 512 + h * 64 + 16 * s + 8 * hi);
    uint4 rr0, rr1, rr2, rr3;
    {
      const bf16_t* rg_ = p.RT + (((size_t)h * 128 + i) * 128 + (tid >> 3)) * 64 + (tid & 7) * 8;
      rr0 = *(const uint4*)(rg_); rr1 = *(const uint4*)(rg_ + 32 * 64); rr2 = *(const uint4*)(rg_ + 64 * 64); rr3 = *(const uint4*)(rg_ + 96 * 64);
    }
    const size_t t = (size_t)(t0 + nl);
    uint2 ga[4], gb[4], gc[4], gd[4];
#pragma unroll
    for (int rg = 0; rg < 4; rg++) {
      const bf16_t* gp = p.RG + t * 1024 + h * 128 + 8 * rg + 4 * hi;
      ga[rg] = *(const uint2*)(gp); gb[rg] = *(const uint2*)(gp + 32); gc[rg] = *(const uint2*)(gp + 64); gd[rg] = *(const uint2*)(gp + 96);
    }
    {
      uint4 kr0, kr1, kr2, kr3, vr0, vr1, vr2, vr3, vr4, vr5, vr6, vr7;
      const bf16_t* kg = p.RK + (size_t)(t0 + (tid >> 3)) * 512 + h * 64 + (tid & 7) * 8;
      const bf16_t* vg = p.RVT + ((size_t)h * 128 + (tid >> 4)) * T_ + t0 + (tid & 15) * 8;
      kr0 = *(const uint4*)(kg); kr1 = *(const uint4*)(kg + (size_t)32 * 512);
      kr2 = *(const uint4*)(kg + (size_t)64 * 512); kr3 = *(const uint4*)(kg + (size_t)96 * 512);
      vr0 = *(const uint4*)(vg); vr1 = *(const uint4*)(vg + (size_t)16 * T_);
      vr2 = *(const uint4*)(vg + (size_t)32 * T_); vr3 = *(const uint4*)(vg + (size_t)48 * T_);
      vr4 = *(const uint4*)(vg + (size_t)64 * T_); vr5 = *(const uint4*)(vg + (size_t)80 * T_);
      vr6 = *(const uint4*)(vg + (size_t)96 * T_); vr7 = *(const uint4*)(vg + (size_t)112 * T_);
      __syncthreads();
      char* kd = sK + (tid >> 3) * KSTR + (tid & 7) * 16;
      *(uint4*)(kd) = kr0; *(uint4*)(kd + 32 * KSTR) = kr1; *(uint4*)(kd + 64 * KSTR) = kr2; *(uint4*)(kd + 96 * KSTR) = kr3;
      char* vd = sV + (tid >> 4) * VSTR + (tid & 15) * 16;
      *(uint4*)(vd) = vr0; *(uint4*)(vd + 16 * VSTR) = vr1; *(uint4*)(vd + 32 * VSTR) = vr2; *(uint4*)(vd + 48 * VSTR) = vr3;
      *(uint4*)(vd + 64 * VSTR) = vr4; *(uint4*)(vd + 80 * VSTR) = vr5; *(uint4*)(vd + 96 * VSTR) = vr6; *(uint4*)(vd + 112 * VSTR) = vr7;
    }
    __syncthreads();
    bf16x8 pb[8];
#pragma unroll
    for (int mb = 0; mb < 4; mb++) {
      if (mb <= w) {
        f32x16 sc;
#pragma unroll
        for (int r = 0; r < 16; r++) sc[r] = 0.f;
        const char* kp = sK + (32 * mb + sig) * KSTR + hi * 16;
#pragma unroll
        for (int s = 0; s < 4; s++) {
          const bf16x8 kf = *(const bf16x8*)(kp + 32 * s);
          sc = __builtin_amdgcn_mfma_f32_32x32x16_bf16(kf, qf[s], sc, 0, 0, 0);
        }
#pragma unroll
        for (int r = 0; r < 16; r++) {
          const int ml = 32 * mb + 16 * (r >> 3) + 8 * hi + (r & 7);
          const int df = nl - ml;
          sc[r] = (df >= 0) ? sc[r] * exp2f(lg * (float)df) : 0.f;
        }
        typedef __attribute__((ext_vector_type(4))) unsigned u32x4;
        u32x4 t0v, t1v;
        t0v[0] = pack2(sc[0], sc[1]); t0v[1] = pack2(sc[2], sc[3]); t0v[2] = pack2(sc[4], sc[5]); t0v[3] = pack2(sc[6], sc[7]);
        t1v[0] = pack2(sc[8], sc[9]); t1v[1] = pack2(sc[10], sc[11]); t1v[2] = pack2(sc[12], sc[13]); t1v[3] = pack2(sc[14], sc[15]);
        pb[2 * mb] = __builtin_bit_cast(bf16x8, t0v);
        pb[2 * mb + 1] = __builtin_bit_cast(bf16x8, t1v);
      } else {
        pb[2 * mb] = (bf16x8){0, 0, 0, 0, 0, 0, 0, 0};
        pb[2 * mb + 1] = (bf16x8){0, 0, 0, 0, 0, 0, 0, 0};
      }
    }
    __syncthreads();
    {
      char* rd = sK + (tid >> 3) * KSTR + (tid & 7) * 16;
      *(uint4*)(rd) = rr0; *(uint4*)(rd + 32 * KSTR) = rr1; *(uint4*)(rd + 64 * KSTR) = rr2; *(uint4*)(rd + 96 * KSTR) = rr3;
    }
    __syncthreads();
    const float xi = exp2f(lg * (float)(nl + 1));
    float sum = 0.f, sumsq = 0.f, mu = 0.f, rs = 0.f;
#pragma unroll 1
    for (int pass = 0; pass < 2; pass++) {
#pragma unroll 1
      for (int eb = 0; eb < 4; eb++) {
        f32x16 a1, a2;
#pragma unroll
        for (int r = 0; r < 16; r++) { a1[r] = 0.f; a2[r] = 0.f; }
        const char* vt = sV + (eb * 32 + l31) * VSTR + hi * 16;
#pragma unroll
        for (int ks = 0; ks < 8; ks++) {
          if ((ks >> 1) <= w) {
            const bf16x8 vf = *(const bf16x8*)(vt + 32 * ks);
            a1 = __builtin_amdgcn_mfma_f32_32x32x16_bf16(vf, pb[ks], a1, 0, 0, 0);
          }
        }
        const char* rt = sK + (eb * 32 + l31) * KSTR + hi * 16;
#pragma unroll
        for (int s = 0; s < 4; s++) {
          const bf16x8 rf = *(const bf16x8*)(rt + 32 * s);
          a2 = __builtin_amdgcn_mfma_f32_32x32x16_bf16(rf, qf[s], a2, 0, 0, 0);
        }
        if (pass == 0) {
#pragma unroll
          for (int r = 0; r < 16; r++) {
            const float v = a1[r] + xi * a2[r];
            sum += v;
            sumsq += v * v;
          }
        } else {
#pragma unroll
          for (int rg = 0; rg < 4; rg++) {
            const int e = 32 * eb + 8 * rg + 4 * hi;
            const float4 gn = *(const float4*)(p.ev_ret_gn + h * 128 + e);
            const unsigned m0_ = (unsigned)-(int)(eb == 0), m1_ = (unsigned)-(int)(eb == 1), m2_ = (unsigned)-(int)(eb == 2), m3_ = (unsigned)-(int)(eb == 3);
            uint2 gr;
            gr.x = (ga[rg].x & m0_) | (gb[rg].x & m1_) | (gc[rg].x & m2_) | (gd[rg].x & m3_);
            gr.y = (ga[rg].y & m0_) | (gb[rg].y & m1_) | (gc[rg].y & m2_) | (gd[rg].y & m3_);
            const float g0 = __uint_as_float(gr.x << 16), g1 = __uint_as_float(gr.x & 0xffff0000u);
            const float g2 = __uint_as_float(gr.y << 16), g3 = __uint_as_float(gr.y & 0xffff0000u);
            const float s0 = g0 / (1.f + __expf(-g0)), s1 = g1 / (1.f + __expf(-g1));
            const float s2 = g2 / (1.f + __expf(-g2)), s3 = g3 / (1.f + __expf(-g3));
            const float v0 = a1[4 * rg] + xi * a2[4 * rg], v1 = a1[4 * rg + 1] + xi * a2[4 * rg + 1];
            const float v2 = a1[4 * rg + 2] + xi * a2[4 * rg + 2], v3 = a1[4 * rg + 3] + xi * a2[4 * rg + 3];
            uint2 o;
            o.x = pack2((v0 - mu) * rs * gn.x * s0, (v1 - mu) * rs * gn.y * s1);
            o.y = pack2((v2 - mu) * rs * gn.z * s2, (v3 - mu) * rs * gn.w * s3);
            *(uint2*)(p.CAT + t * 1536 + 512 + h * 128 + e) = o;
          }
        }
      }
      if (pass == 0) {
        sum += __shfl_xor(sum, 32);
        sumsq += __shfl_xor(sumsq, 32);
        mu = sum * (1.f / 128.f);
        const float var = fmaxf(sumsq * (1.f / 128.f) - mu * mu, 0.f);
        rs = rsqrtf(var + 1e-6f);
      }
    }
  }
}


#define CE_DESC(x, y) { const float mx_ = fmaxf(x, y), mn_ = fminf(x, y); x = mx_; y = mn_; }

template <int N>
__device__ __forceinline__ void bitonic_sort_desc(float (&a)[N]) {
#pragma unroll
  for (int k = 2; k <= N; k <<= 1)
#pragma unroll
    for (int j = k >> 1; j > 0; j >>= 1)
#pragma unroll
      for (int i = 0; i < N; i++) {
        const int l = i ^ j;
        if (l > i) {
          const float mx = fmaxf(a[i], a[l]), mn = fminf(a[i], a[l]);
          if ((i & k) == 0) { a[i] = mx; a[l] = mn; }
          else { a[i] = mn; a[l] = mx; }
        }
      }
}
__device__ __forceinline__ void merge_top16(float (&a)[16], const float (&b)[16]) {
#pragma unroll
  for (int i = 0; i < 16; i++) a[i] = fmaxf(a[i], b[15 - i]);
#pragma unroll
  for (int j = 8; j > 0; j >>= 1)
#pragma unroll
    for (int i = 0; i < 16; i++) {
      const int l = i ^ j;
      if (l > i) CE_DESC(a[i], a[l]);
    }
}
__device__ __forceinline__ float pack_low(float v, unsigned mask, unsigned bits) {
  return __uint_as_float((__float_as_uint(v) & ~mask) | bits);
}

__device__ __forceinline__ void route_unit(const Params& p, const bf16_t* keys, int h, int t0, const bf16_t* qrow,
                                           unsigned char* ltab) {
  const int lane = tidx() & 63;
  const int l31 = lane & 31, hi = lane >> 5;
  {
    const int t = t0 + l31;
    float top[2][16];
#pragma unroll
    for (int pp = 0; pp < 2; pp++) {
      bf16x8 qf[4];
#pragma unroll
      for (int s = 0; s < 4; s++) qf[s] = *(const bf16x8*)(qrow + pp * 64 + 16 * s + 8 * hi);
      float v[4][16];
#pragma unroll
      for (int nbk = 0; nbk < 4; nbk++) {
        f32x16 acc;
#pragma unroll
        for (int r = 0; r < 16; r++) acc[r] = 0.f;
        const bf16_t* kp = keys + (((size_t)h * 2 + pp) * 128 + nbk * 32 + l31) * 64 + 8 * hi;
#pragma unroll
        for (int s = 0; s < 4; s++) {
          const bf16x8 kf = *(const bf16x8*)(kp + 16 * s);
          acc = __builtin_amdgcn_mfma_f32_32x32x16_bf16(kf, qf[s], acc, 0, 0, 0);
        }
#pragma unroll
        for (int r = 0; r < 16; r++)
          v[nbk][r] = pack_low(acc[r], 127u, (unsigned)(32 * nbk + (r & 3) + 8 * (r >> 2) + 4 * hi));
        bitonic_sort_desc<16>(v[nbk]);
      }
      merge_top16(v[0], v[1]);
      merge_top16(v[2], v[3]);
      merge_top16(v[0], v[2]);
      float o[16];
#pragma unroll
      for (int i = 0; i < 16; i++) o[i] = __shfl_xor(v[0][i], 32);
      merge_top16(v[0], o);
#pragma unroll
      for (int i = 0; i < 16; i++) top[pp][i] = v[0][i];
    }
    {
      unsigned w[8];
#pragma unroll
      for (int k = 0; k < 8; k++) {
        const int pp = k >> 2, i0 = (k & 3) * 4;
        w[k] = (__float_as_uint(top[pp][i0]) & 127u) | ((__float_as_uint(top[pp][i0 + 1]) & 127u) << 8) |
               ((__float_as_uint(top[pp][i0 + 2]) & 127u) << 16) | ((__float_as_uint(top[pp][i0 + 3]) & 127u) << 24);
      }
      *(uint4*)(ltab) = make_uint4(w[0], w[1], w[2], w[3]);
      *(uint4*)(ltab + 16) = make_uint4(w[4], w[5], w[6], w[7]);
    }
#define CAND(a, b) pack_low(top[0][a] + top[1][b], 255u, (unsigned)(((a) << 4) | (b)))
    const float NEG = -INFINITY;
    float g0[16], g1[16], g2[16], g3[16];
#pragma unroll
    for (int b = 0; b < 16; b++) g0[b] = CAND(0, b);
#pragma unroll
    for (int b = 0; b < 8; b++) g1[b] = CAND(1, b);
    g1[8] = CAND(6, 0); g1[9] = CAND(6, 1); g1[10] = CAND(7, 0); g1[11] = CAND(7, 1);
    g1[12] = NEG; g1[13] = NEG; g1[14] = NEG; g1[15] = NEG;
    g2[0] = CAND(2, 0); g2[1] = CAND(2, 1); g2[2] = CAND(2, 2); g2[3] = CAND(2, 3); g2[4] = CAND(2, 4);
    g2[5] = CAND(3, 0); g2[6] = CAND(3, 1); g2[7] = CAND(3, 2); g2[8] = CAND(3, 3);
    g2[9] = CAND(4, 0); g2[10] = CAND(4, 1); g2[11] = CAND(4, 2);
    g2[12] = CAND(5, 0); g2[13] = CAND(5, 1); g2[14] = NEG; g2[15] = NEG;
#pragma unroll
    for (int a = 8; a < 16; a++) g3[a - 8] = CAND(a, 0);
#pragma unroll
    for (int i = 8; i < 16; i++) g3[i] = NEG;
#undef CAND
    bitonic_sort_desc<16>(g1);
    bitonic_sort_desc<16>(g2);
    merge_top16(g0, g1);
    merge_top16(g2, g3);
    merge_top16(g0, g2);
    float e[16], sum = 0.f;
#pragma unroll
    for (int r = 0; r < 16; r++) {
      e[r] = __expf(g0[r] - g0[0]);
      sum += e[r];
    }
    const float inv = 1.f / sum;
    int id[8];
    float gt[8];
#pragma unroll
    for (int r = 0; r < 8; r++) {
      const unsigned hm = (unsigned)(-hi);
      const float gv = __uint_as_float((__float_as_uint(g0[8 + r]) & hm) | (__float_as_uint(g0[r]) & ~hm));
      const float ev = __uint_as_float((__float_as_uint(e[8 + r]) & hm) | (__float_as_uint(e[r]) & ~hm));
      const unsigned ab = __float_as_uint(gv) & 255u;
      const int i1 = ltab[ab >> 4], i2 = ltab[16 + (ab & 15u)];
      id[r] = i1 * 128 + i2;
      gt[r] = ev * inv;
    }
    int* ep = p.EIDX + (size_t)t * 128 + h * 16 + 8 * hi;
    float* gp = p.GATE + (size_t)t * 128 + h * 16 + 8 * hi;
    *(int4*)ep = make_int4(id[0], id[1], id[2], id[3]);
    *(int4*)(ep + 4) = make_int4(id[4], id[5], id[6], id[7]);
    *(float4*)gp = make_float4(gt[0], gt[1], gt[2], gt[3]);
    *(float4*)(gp + 4) = make_float4(gt[4], gt[5], gt[6], gt[7]);
  }
}

__device__ __forceinline__ void unpack8(const uint4 u, float* f) {
  f[0] = __uint_as_float(u.x << 16); f[1] = __uint_as_float(u.x & 0xffff0000u);
  f[2] = __uint_as_float(u.y << 16); f[3] = __uint_as_float(u.y & 0xffff0000u);
  f[4] = __uint_as_float(u.z << 16); f[5] = __uint_as_float(u.z & 0xffff0000u);
  f[6] = __uint_as_float(u.w << 16); f[7] = __uint_as_float(u.w & 0xffff0000u);
}

#define PU_SCALE 64.f
#define PV_SCALE 8.f
typedef __attribute__((ext_vector_type(2))) float f32x2v;

__device__ __forceinline__ void convert_fp8(const float* __restrict__ src, unsigned char* __restrict__ dst, size_t n, float scale,
                                            int bid, int nb) {
  const size_t nvec = n / 16;
  for (size_t i = (size_t)bid * NTHREADS + tidx(); i < nvec; i += (size_t)nb * NTHREADS) {
    const float4* sp = (const float4*)src + 4 * i;
    const float4 a = sp[0], b = sp[1], c = sp[2], d = sp[3];
    int w0 = 0, w1 = 0, w2 = 0, w3 = 0;
    w0 = __builtin_amdgcn_cvt_pk_fp8_f32(a.x * scale, a.y * scale, w0, false);
    w0 = __builtin_amdgcn_cvt_pk_fp8_f32(a.z * scale, a.w * scale, w0, true);
    w1 = __builtin_amdgcn_cvt_pk_fp8_f32(b.x * scale, b.y * scale, w1, false);
    w1 = __builtin_amdgcn_cvt_pk_fp8_f32(b.z * scale, b.w * scale, w1, true);
    w2 = __builtin_amdgcn_cvt_pk_fp8_f32(c.x * scale, c.y * scale, w2, false);
    w2 = __builtin_amdgcn_cvt_pk_fp8_f32(c.z * scale, c.w * scale, w2, true);
    w3 = __builtin_amdgcn_cvt_pk_fp8_f32(d.x * scale, d.y * scale, w3, false);
    w3 = __builtin_amdgcn_cvt_pk_fp8_f32(d.z * scale, d.w * scale, w3, true);
    ((int4*)dst)[i] = make_int4(w0, w1, w2, w3);
  }
}

__device__ __forceinline__ unsigned pack4_i8(float a, float b, float c, float d, float inv) {
  const int qa = __float2int_rn(a * inv), qb = __float2int_rn(b * inv), qc = __float2int_rn(c * inv), qd = __float2int_rn(d * inv);
  return (unsigned)(qa & 255) | ((unsigned)(qb & 255) << 8) | ((unsigned)(qc & 255) << 16) | ((unsigned)qd << 24);
}
__device__ __forceinline__ void convert_i8_rows(const float* __restrict__ src, unsigned char* __restrict__ dst,
                                                float* __restrict__ scales, int nrows, int bid, int nb) {
  const int lane = tidx() & 63, wid = tidx() >> 6;
  for (int row = bid * 4 + wid; row < nrows; row += nb * 4) {
    const float4* sp = (const float4*)(src + (size_t)row * 1024 + lane * 16);
    const float4 a = sp[0], b = sp[1], c = sp[2], d = sp[3];
    float mx = fmaxf(fmaxf(fmaxf(fabsf(a.x), fabsf(a.y)), fmaxf(fabsf(a.z), fabsf(a.w))),
                     fmaxf(fmaxf(fabsf(b.x), fabsf(b.y)), fmaxf(fabsf(b.z), fabsf(b.w))));
    mx = fmaxf(mx, fmaxf(fmaxf(fmaxf(fabsf(c.x), fabsf(c.y)), fmaxf(fabsf(c.z), fabsf(c.w))),
                         fmaxf(fmaxf(fabsf(d.x), fabsf(d.y)), fmaxf(fabsf(d.z), fabsf(d.w)))));
    mx = wave_max(mx);
    const float inv = mx > 0.f ? 127.f / mx : 0.f;
    uint4 w;
    w.x = pack4_i8(a.x, a.y, a.z, a.w, inv);
    w.y = pack4_i8(b.x, b.y, b.z, b.w, inv);
    w.z = pack4_i8(c.x, c.y, c.z, c.w, inv);
    w.w = pack4_i8(d.x, d.y, d.z, d.w, inv);
    *(uint4*)(dst + (size_t)row * 1024 + lane * 16) = w;
    if (lane == 0) scales[row] = mx * (1.f / 127.f);
  }
}
__device__ __forceinline__ float dot16_i8(const uint4 r, const uint4 x) {
  int s = __builtin_amdgcn_sdot4((int)r.x, (int)x.x, 0, false);
  s = __builtin_amdgcn_sdot4((int)r.y, (int)x.y, s, false);
  s = __builtin_amdgcn_sdot4((int)r.z, (int)x.z, s, false);
  s = __builtin_amdgcn_sdot4((int)r.w, (int)x.w, s, false);
  return (float)s;
}

__device__ __forceinline__ float dot16_fp8(const uint4 r, const f32x2v* x) {
  const f32x2v a0 = __builtin_amdgcn_cvt_pk_f32_fp8((int)r.x, false), a1 = __builtin_amdgcn_cvt_pk_f32_fp8((int)r.x, true);
  const f32x2v b0 = __builtin_amdgcn_cvt_pk_f32_fp8((int)r.y, false), b1 = __builtin_amdgcn_cvt_pk_f32_fp8((int)r.y, true);
  const f32x2v c0 = __builtin_amdgcn_cvt_pk_f32_fp8((int)r.z, false), c1 = __builtin_amdgcn_cvt_pk_f32_fp8((int)r.z, true);
  const f32x2v d0 = __builtin_amdgcn_cvt_pk_f32_fp8((int)r.w, false), d1 = __builtin_amdgcn_cvt_pk_f32_fp8((int)r.w, true);
  f32x2v s = a0 * x[0];
  f32x2v t = a1 * x[1];
  s = __builtin_elementwise_fma(b0, x[2], s);
  t = __builtin_elementwise_fma(b1, x[3], t);
  s = __builtin_elementwise_fma(c0, x[4], s);
  t = __builtin_elementwise_fma(c1, x[5], t);
  s = __builtin_elementwise_fma(d0, x[6], s);
  t = __builtin_elementwise_fma(d1, x[7], t);
  s += t;
  return s[0] + s[1];
}
__device__ __forceinline__ void axpy16_fp8(const uint4 r, float a, f32x2v* acc) {
  const f32x2v a0 = __builtin_amdgcn_cvt_pk_f32_fp8((int)r.x, false), a1 = __builtin_amdgcn_cvt_pk_f32_fp8((int)r.x, true);
  const f32x2v b0 = __builtin_amdgcn_cvt_pk_f32_fp8((int)r.y, false), b1 = __builtin_amdgcn_cvt_pk_f32_fp8((int)r.y, true);
  const f32x2v c0 = __builtin_amdgcn_cvt_pk_f32_fp8((int)r.z, false), c1 = __builtin_amdgcn_cvt_pk_f32_fp8((int)r.z, true);
  const f32x2v d0 = __builtin_amdgcn_cvt_pk_f32_fp8((int)r.w, false), d1 = __builtin_amdgcn_cvt_pk_f32_fp8((int)r.w, true);
  const f32x2v av = {a, a};
  acc[0] = __builtin_elementwise_fma(av, a0, acc[0]);
  acc[1] = __builtin_elementwise_fma(av, a1, acc[1]);
  acc[2] = __builtin_elementwise_fma(av, b0, acc[2]);
  acc[3] = __builtin_elementwise_fma(av, b1, acc[3]);
  acc[4] = __builtin_elementwise_fma(av, c0, acc[4]);
  acc[5] = __builtin_elementwise_fma(av, c1, acc[5]);
  acc[6] = __builtin_elementwise_fma(av, d0, acc[6]);
  acc[7] = __builtin_elementwise_fma(av, d1, acc[7]);
}
#define DPP_F(v, ctrl) __int_as_float(__builtin_amdgcn_update_dpp(0, __float_as_int(v), ctrl, 0xf, 0xf, false))
#define SWZ_F(v, pat) __int_as_float(__builtin_amdgcn_ds_swizzle(__float_as_int(v), pat))
#define RDL_F(v, l) __int_as_float(__builtin_amdgcn_readlane(__float_as_int(v), l))

#define PY_WSZ 16384
__device__ __forceinline__ void peer_experts_uv(const Params& p, const float* __restrict__ gx, const float* __restrict__ ssq,
                                                const float* __restrict__ gnext, int final, char* smem, int bid, int nb) {
  const int lane = tidx() & 63, wid = tidx() >> 6;
  const bool b0 = lane & 1, b1 = (lane >> 1) & 1, b2 = (lane >> 2) & 1;
  const int myu = 4 * (int)b0 + 2 * (int)b1 + (int)b2;
  int* se = (int*)(smem + wid * PY_WSZ);
  float* sg = (float*)(smem + wid * PY_WSZ + 4096);
  float* sa = (float*)(smem + wid * PY_WSZ + 8192);
  float* ssc = (float*)(smem + wid * PY_WSZ + 12288);
  const unsigned long long ltmask = (1ull << lane) - 1ull;
  for (int tt = bid * 4 + wid; tt < T_ / 8; tt += nb * 4) {
    const int t = __builtin_amdgcn_readfirstlane(tt) * 8;
#pragma unroll 1
    for (int j = 0; j < 8; j++) {
      const int e0 = p.EIDX[(size_t)(t + j) * 128 + lane], e1 = p.EIDX[(size_t)(t + j) * 128 + 64 + lane];
      const float g0 = p.GATE[(size_t)(t + j) * 128 + lane], g1 = p.GATE[(size_t)(t + j) * 128 + 64 + lane];
      const int k0 = e0 >> 10, k1 = e1 >> 10;
      int base = 0, pos0 = 0, pos1 = 0;
#pragma unroll 8
      for (int k = 0; k < 16; k++) {
        const unsigned long long m0 = __ballot(k0 == k), m1 = __ballot(k1 == k);
        const int c0 = __popcll(m0);
        if (k0 == k) pos0 = base + __popcll(m0 & ltmask);
        if (k1 == k) pos1 = base + c0 + __popcll(m1 & ltmask);
        base += c0 + __popcll(m1);
      }
      se[j * 128 + pos0] = e0; sg[j * 128 + pos0] = g0; ssc[j * 128 + pos0] = p.PUS[e0];
      se[j * 128 + pos1] = e1; sg[j * 128 + pos1] = g1; ssc[j * 128 + pos1] = p.PUS[e1];
    }
#define PY_DECL(S) uint4 S##r0, S##r1, S##r2, S##r3, S##r4, S##r5, S##r6, S##r7;
#define PY_LD1(S, TAB, n, kk) S##r##n = *(const uint4*)(TAB + (size_t)__builtin_amdgcn_readfirstlane(se[(kk) + n]) * DM + lane * 16);
#define PY_LOAD(S, TAB, kk) { PY_LD1(S, TAB, 0, kk) PY_LD1(S, TAB, 1, kk) PY_LD1(S, TAB, 2, kk) PY_LD1(S, TAB, 3, kk) \
                              PY_LD1(S, TAB, 4, kk) PY_LD1(S, TAB, 5, kk) PY_LD1(S, TAB, 6, kk) PY_LD1(S, TAB, 7, kk) }
    {
      uint4 xq[8];
      float xsv[8];
      {
        float gv[16];
#pragma unroll
        for (int c = 0; c < 4; c++) {
          const float4 g4 = *(const float4*)(gx + lane * 16 + 4 * c);
          gv[4 * c] = g4.x; gv[4 * c + 1] = g4.y; gv[4 * c + 2] = g4.z; gv[4 * c + 3] = g4.w;
        }
#pragma unroll
        for (int j = 0; j < 8; j++) {
          const float* hp = p.out + (size_t)(t + j) * DM + lane * 16;
          const float sx = rsqrtf(ssq_sum<16>(ssq, t + j) * (1.f / DM) + 1e-6f);
          float xv[16];
#pragma unroll
          for (int c = 0; c < 4; c++) {
            const float4 a4 = *(const float4*)(hp + 4 * c);
            xv[4 * c] = a4.x * sx * gv[4 * c]; xv[4 * c + 1] = a4.y * sx * gv[4 * c + 1];
            xv[4 * c + 2] = a4.z * sx * gv[4 * c + 2]; xv[4 * c + 3] = a4.w * sx * gv[4 * c + 3];
          }
          float mx = 0.f;
#pragma unroll
          for (int i = 0; i < 16; i++) mx = fmaxf(mx, fabsf(xv[i]));
          mx = wave_max(mx);
          const float inv = mx > 0.f ? 127.f / mx : 0.f;
          xsv[j] = mx * (1.f / 127.f);
          xq[j].x = pack4_i8(xv[0], xv[1], xv[2], xv[3], inv); xq[j].y = pack4_i8(xv[4], xv[5], xv[6], xv[7], inv);
          xq[j].z = pack4_i8(xv[8], xv[9], xv[10], xv[11], inv); xq[j].w = pack4_i8(xv[12], xv[13], xv[14], xv[15], inv);
        }
      }
#define PY_DOTS(S, X, XS, kk)                                                                                              \
  {                                                                                                                      \
    const float d0 = dot16_i8(S##r0, X), d1 = dot16_i8(S##r1, X), d2 = dot16_i8(S##r2, X), d3 = dot16_i8(S##r3, X);      \
    const float d4 = dot16_i8(S##r4, X), d5 = dot16_i8(S##r5, X), d6 = dot16_i8(S##r6, X), d7 = dot16_i8(S##r7, X);      \
    const float e0 = (b0 ? d4 : d0) + DPP_F((b0 ? d0 : d4), 0xB1);                                                       \
    const float e1 = (b0 ? d5 : d1) + DPP_F((b0 ? d1 : d5), 0xB1);                                                       \
    const float e2 = (b0 ? d6 : d2) + DPP_F((b0 ? d2 : d6), 0xB1);                                                       \
    const float e3 = (b0 ? d7 : d3) + DPP_F((b0 ? d3 : d7), 0xB1);                                                       \
    const float f0 = (b1 ? e2 : e0) + DPP_F((b1 ? e0 : e2), 0x4E);                                                       \
    const float f1 = (b1 ? e3 : e1) + DPP_F((b1 ? e1 : e3), 0x4E);                                                       \
    float gs = (b2 ? f1 : f0) + SWZ_F((b2 ? f0 : f1), 0x101F);                                                           \
    gs += DPP_F(gs, 0x128);                                                                                              \
    gs += SWZ_F(gs, 0x401F);                                                                                             \
    gs += __shfl_xor(gs, 32);                                                                                            \
    const float z_ = gs * (ssc[(kk) + myu] * XS);                                                                        \
    const float a_ = 0.5f * z_ * (1.f + erff(z_ * 0.70710678118654752f)) * sg[(kk) + myu] * (1.f / PV_SCALE);            \
    if (lane < 8) sa[(kk) + myu] = a_;                                                                                   \
  }
      PY_DECL(A) PY_DECL(B)
      PY_LOAD(A, p.PU8, 0)
#pragma unroll 1
      for (int g8 = 0; g8 < 128; g8 += 8) {
#pragma unroll
        for (int q = 0; q < 4; q++) {
          PY_LOAD(B, p.PU8, (2 * q + 1) * 128 + g8)
          PY_DOTS(A, xq[2 * q], xsv[2 * q], (2 * q) * 128 + g8)
          if (q < 3) { PY_LOAD(A, p.PU8, (2 * q + 2) * 128 + g8) }
          else if (g8 + 8 < 128) { PY_LOAD(A, p.PU8, g8 + 8) }
          PY_DOTS(B, xq[2 * q + 1], xsv[2 * q + 1], (2 * q + 1) * 128 + g8)
        }
      }
#undef PY_DOTS
    }
#define PY_AXPY(S, ACC, kk)                                                                                              \
  {                                                                                                                      \
    axpy16_fp8(S##r0, sa[(kk) + 0], ACC); axpy16_fp8(S##r1, sa[(kk) + 1], ACC);                                          \
    axpy16_fp8(S##r2, sa[(kk) + 2], ACC); axpy16_fp8(S##r3, sa[(kk) + 3], ACC);                                          \
    axpy16_fp8(S##r4, sa[(kk) + 4], ACC); axpy16_fp8(S##r5, sa[(kk) + 5], ACC);                                          \
    axpy16_fp8(S##r6, sa[(kk) + 6], ACC); axpy16_fp8(S##r7, sa[(kk) + 7], ACC);                                          \
  }
#define PY_EPI(HP, CV, j)                                                                                                \
  {                                                                                                                      \
    float hv[16], gv[16];                                                                                                \
    _Pragma("unroll") for (int c = 0; c < 4; c++) {                                                                      \
      const float4 a4 = *(const float4*)(HP + 4 * c);                                                                    \
      const float4 g4 = *(const float4*)(gnext + lane * 16 + 4 * c);                                                     \
      hv[4 * c] = a4.x; hv[4 * c + 1] = a4.y; hv[4 * c + 2] = a4.z; hv[4 * c + 3] = a4.w;                                \
      gv[4 * c] = g4.x; gv[4 * c + 1] = g4.y; gv[4 * c + 2] = g4.z; gv[4 * c + 3] = g4.w;                                \
    }                                                                                                                    \
    float ss = 0.f;                                                                                                      \
    _Pragma("unroll") for (int i = 0; i < 16; i++) { hv[i] += CV[i >> 1][i & 1]; ss += hv[i] * hv[i]; }                  \
    ss = wave_sum(ss);                                                                                                   \
    const float sc = rsqrtf(ss * (1.f / DM) + 1e-6f);                                                                    \
    if (final) {                                                                                                         \
      _Pragma("unroll") for (int c = 0; c < 4; c++)                                                                      \
        *(float4*)(HP + 4 * c) = make_float4(hv[4 * c] * sc * gv[4 * c], hv[4 * c + 1] * sc * gv[4 * c + 1],            \
                                             hv[4 * c + 2] * sc * gv[4 * c + 2], hv[4 * c + 3] * sc * gv[4 * c + 3]);    \
    } else {                                                                                                             \
      _Pragma("unroll") for (int c = 0; c < 4; c++)                                                                      \
        *(float4*)(HP + 4 * c) = make_float4(hv[4 * c], hv[4 * c + 1], hv[4 * c + 2], hv[4 * c + 3]);                    \
      float nv[16];                                                                                                      \
      _Pragma("unroll") for (int i = 0; i < 16; i++) nv[i] = hv[i] * sc * gv[i];                                         \
      bf16_t* xo = p.XN + (size_t)(t + j) * DM + lane * 16;                                                              \
      store8bf(xo, nv);                                                                                                  \
      store8bf(xo + 8, nv + 8);                                                                                          \
    }                                                                                                                    \
  }
#pragma unroll 1
    for (int q = 0; q < 4; q++) {
      const int l0 = (2 * q) * 128, l1 = l0 + 128;
      float* hp0 = p.out + (size_t)(t + 2 * q) * DM + lane * 16;
      float* hp1 = hp0 + DM;
      f32x2v c0[8], c1[8];
#pragma unroll
      for (int j = 0; j < 8; j++) { c0[j] = (f32x2v){0.f, 0.f}; c1[j] = c0[j]; }
      PY_DECL(A) PY_DECL(B)
      PY_LOAD(A, p.PV8, l0)
#pragma unroll 1
      for (int k0 = 0; k0 < 128; k0 += 8) {
        PY_LOAD(B, p.PV8, l1 + k0)
        PY_AXPY(A, c0, l0 + k0)
        if (k0 + 8 < 128) PY_LOAD(A, p.PV8, l0 + k0 + 8)
        PY_AXPY(B, c1, l1 + k0)
      }
      PY_EPI(hp0, c0, 2 * q)
      PY_EPI(hp1, c1, 2 * q + 1)
    }
#undef PY_AXPY
#undef PY_EPI
#undef PY_DECL
#undef PY_LD1
#undef PY_LOAD
  }
}

#define XB_TMO      128
#define XB_XCNT(j)  (256  + 64 * (j))
#define XB_XSUB(j)  (1280 + 64 * (j))
#define XB_XGEN(j)  (2304 + 64 * (j))
#define XB_TOP      3328
#define XB_TOPGEN   3392
#define XCD_BAR_WORDS 3456
#define XB_SPIN_CAP (1u << 18)
#define LAS __attribute__((address_space(3)))

__device__ __forceinline__ unsigned xb_ld(unsigned* p)              { return __hip_atomic_load(p, __ATOMIC_RELAXED, __HIP_MEMORY_SCOPE_AGENT); }
__device__ __forceinline__ unsigned xb_add(unsigned* p, unsigned v) { return __hip_atomic_fetch_add(p, v, __ATOMIC_RELAXED, __HIP_MEMORY_SCOPE_AGENT); }
__device__ __forceinline__ unsigned xb_xcc_id() { return (unsigned)__builtin_amdgcn_s_getreg((3 << 11) | 20) & 0xFu; }
#define XB_SPIN(cond, bar) do { unsigned _sp = 0; while (cond) { __builtin_amdgcn_s_sleep(1); \
    if ((++_sp & 255u) == 0u) { if (xb_ld(&(bar)[XB_TMO])) break; if (_sp > XB_SPIN_CAP) { atomicAdd(&(bar)[XB_TMO], 1u); break; } } } } while (0)

struct XcdBarrier {
    unsigned* bar; unsigned x;
    volatile LAS unsigned* st;
};

__device__ __forceinline__ XcdBarrier xcd_barrier_post(unsigned* bar, volatile LAS unsigned* st) {
    XcdBarrier b; b.bar = bar; b.x = xb_xcc_id(); b.st = st;
    if (tidx() == 0) (void)xb_add(&bar[XB_XCNT(b.x)], 1u);
    return b;
}
__device__ __forceinline__ void xcd_barrier_complete(unsigned* bar, unsigned x, unsigned& nloc, unsigned& nx) {
    const unsigned G = gridDim.x * gridDim.y * gridDim.z;
    unsigned sum, cnt, mine, sp = 0u;
    for (;;) {
        sum = 0u; cnt = 0u; mine = 0u;
#pragma unroll
        for (unsigned j = 0; j < 16; ++j) { const unsigned c = xb_ld(&bar[XB_XCNT(j)]); sum += c; cnt += (c > 0u) ? 1u : 0u; mine = (j == x) ? c : mine; }
        if (sum == G) break;
        __builtin_amdgcn_s_sleep(1);
        if ((++sp & 255u) == 0u) { if (xb_ld(&bar[XB_TMO])) break; if (sp > XB_SPIN_CAP) { atomicAdd(&bar[XB_TMO], 1u); break; } }
    }
    nloc = mine > 0u ? mine : 1u; nx = cnt > 0u ? cnt : 1u;
}

__device__ __forceinline__ void xcd_barrier(const XcdBarrier& b) {
    asm volatile("s_waitcnt vmcnt(0)" ::: "memory");
    __syncthreads();
    if (tidx() == 0) {
        unsigned* bar = b.bar;
        __builtin_amdgcn_s_waitcnt(0);
        unsigned nloc = b.st[0], nx = b.st[1];
        if (nloc == 0u) { xcd_barrier_complete(bar, b.x, nloc, nx); b.st[0] = nloc; b.st[1] = nx; }
        const unsigned old = xb_add(&bar[XB_XSUB(b.x)], 1u);
        const unsigned gen = old / nloc;
        if (old + 1u == (gen + 1u) * nloc) {
            __builtin_amdgcn_fence(__ATOMIC_RELEASE, "agent");
            asm volatile("s_waitcnt vmcnt(0)" ::: "memory");
            const unsigned og = xb_add(&bar[XB_TOP], 1u);
            const unsigned tg = og / nx;
            if (og + 1u == (tg + 1u) * nx) xb_add(&bar[XB_TOPGEN], 1u);
            else XB_SPIN(xb_ld(&bar[XB_TOPGEN]) == tg, bar);
            __builtin_amdgcn_fence(__ATOMIC_ACQUIRE, "agent");
            xb_add(&bar[XB_XGEN(b.x)], 1u);
            asm volatile("s_waitcnt vmcnt(0)" ::: "memory");
        } else {
            XB_SPIN(xb_ld(&bar[XB_XGEN(b.x)]) == gen, bar);
            __builtin_amdgcn_fence(__ATOMIC_ACQUIRE, "agent");
            asm volatile("s_waitcnt vmcnt(0)" ::: "memory");
        }
    }
    __syncthreads();
}


#define NPHASES 14

template <int PH>
__device__ __forceinline__ void run_phase(const Params& p, char* smem, int bid, int nb) {
  float* fl = (float*)smem;
  if constexpr (PH == 0) {
    transpose_w(p.ev_w_in, 1024, 4608, p.WT_in, 4608, fl, bid, nb);
    transpose_w(p.ev_w_o, 1536, 1024, p.WT_o0, 1024, fl, bid, nb);
    transpose_w(p.od_w_down, 1024, 800, p.WT_down, 896, fl, bid, nb);
    transpose_w(p.od_w_uq, 512, 1536, p.WT_uq, 1536, fl, bid, nb, p.od_q_norm);
    transpose_w(p.od_w_ukv, 256, 2048, p.WT_ukv, 2048, fl, bid, nb, p.od_kv_norm);
    transpose_w(p.od_w_o, 1024, 1024, p.WT_o1, 1024, fl, bid, nb);
    transpose_w(p.peer_wq, 1024, 1024, p.WT_pq, 1024, fl, bid, nb, p.ffn_norm);
    transpose_w(p.peer_wq + 1024 * 1024, 1024, 1024, p.WT_pq + 1024 * 1024, 1024, fl, bid, nb, p.ffn_norm + 1024);
    rope_tables(p.COSM, p.SINM, 8, 500000.0, bid, nb);
    rope_tables(p.COSR, p.SINR, 32, 10000.0, bid, nb);
    rope_tables(p.COSL, p.SINL, 16, 500000.0, bid, nb);
    convert_bf16(p.peer_keys, p.PKEYS, (size_t)2 * 8 * 2 * 128 * 64, bid, nb);
    rmsnorm_rows(p.x, p.attn_norm, p.XN, bid, nb);
    if (bid == 0) { p.GCNT[tidx()] = 0u; p.GCNT[256 + tidx()] = 0u; }
  }
  if constexpr (PH == 1) {
    const bool cf = (bid >> 8) & 1;
    if (cf) {
      convert_i8_rows(p.peer_u, p.PU8, p.PUS, 16384, bid, nb);
      convert_fp8(p.peer_v, p.PV8, (size_t)16384 * 1024, PV_SCALE, bid, nb);
    }
    gemm_mfma(p.XN, 1024, p.WT_in, 1024, T_, 4608, 1024,
              EpiInProj{p.MQ, p.MK, p.MVT, p.RQ, p.RK, p.RKTZ, p.RVT, p.RG, p.COSM, p.SINM, p.COSR, p.SINR}, smem, bid, nb);
    if (!cf) {
      convert_i8_rows(p.peer_u, p.PU8, p.PUS, 16384, bid, nb);
      convert_fp8(p.peer_v, p.PV8, (size_t)16384 * 1024, PV_SCALE, bid, nb);
    }
  }
  if constexpr (PH == 2) {
    moba_kmean(p, bid, nb);
    retention_state(p, bid, nb);
  }
  if constexpr (PH == 3) {
    moba_select(p, smem, bid, nb);
    retention_prefix(p, bid, nb);
  }
  if constexpr (PH == 4) {
    moba_gathered(p, smem, bid, nb);
    retention_out(p, smem, bid, nb);
  }
  if constexpr (PH == 5) { moba_own_merge(p, smem, bid, nb); }
  if constexpr (PH == 6) { gemm_mfma(p.CAT, 1536, p.WT_o0, 1536, T_, 1024, 1536, EpiResSSQ{p.x, p.out, p.XN, p.SSQ0}, smem, bid, nb); }
  if constexpr (PH == 7) { gemm_mfma(p.XN, 1024, p.WT_pq, 1024, T_, 1024, 1024, EpiRoute{&p, p.SSQ0, 0, smem}, smem, bid, nb); }
  if constexpr (PH == 8) { peer_experts_uv(p, p.ffn_norm, p.SSQ0, p.attn_norm + 1024, 0, smem, bid, nb); }
  if constexpr (PH == 9) {
    gemm_mfma(p.XN, 1024, p.WT_down, 1024, T_, 896, 1024, EpiDown{p.CQN, p.CKVN, p.K1, p.SSQQ, p.SSQKV, p.COSL, p.SINL}, smem, bid, nb);
  }
  if constexpr (PH == 10) {
    gemm_mfma(p.CQN, 512, p.WT_uq, 512, T_, 1536, 512, EpiUQ{p.Q1, p.COSL, p.SINL, p.SSQQ}, smem, bid, nb);
    gemm_mfma(p.CKVN, 256, p.WT_ukv, 256, T_, 2048, 256, EpiUKV{p.K1, p.V1T, p.SSQKV}, smem, bid, nb);
  }
  if constexpr (PH == 11) {
    const bool cf = (bid >> 8) & 1;
    if (cf) {
      convert_i8_rows(p.peer_u + (size_t)16384 * 1024, p.PU8, p.PUS, 16384, bid, nb);
      convert_fp8(p.peer_v + (size_t)16384 * 1024, p.PV8, (size_t)16384 * 1024, PV_SCALE, bid, nb);
    }
    attn_causal<96>(p.Q1, p.K1, p.V1T, p.O1, 1024, 16, smem, bid, nb);
    if (!cf) {
      convert_i8_rows(p.peer_u + (size_t)16384 * 1024, p.PU8, p.PUS, 16384, bid, nb);
      convert_fp8(p.peer_v + (size_t)16384 * 1024, p.PV8, (size_t)16384 * 1024, PV_SCALE, bid, nb);
    }
  }
  if constexpr (PH == 12) { gemm_mfma(p.O1, 1024, p.WT_o1, 1024, T_, 1024, 1024, EpiResSSQ{p.out, p.out, p.XN, p.SSQ1}, smem, bid, nb); }
  if constexpr (PH == 13) { gemm_mfma(p.XN, 1024, p.WT_pq + 1024 * 1024, 1024, T_, 1024, 1024, EpiRoute{&p, p.SSQ1, 1, smem}, smem, bid, nb); }
  if constexpr (PH == 14) { peer_experts_uv(p, p.ffn_norm + 1024, p.SSQ1, p.final_norm, 1, smem, bid, nb); }
}

#define SMEM_BYTES 65536

template <int PH>
__global__ void __launch_bounds__(NTHREADS, 2) mk1(Params p) {
  __shared__ __attribute__((aligned(16))) char smem[SMEM_BYTES];
  run_phase<PH>(p, smem, blockIdx.x, gridDim.x);
}

#if MEGA
typedef const __attribute__((address_space(4))) Params CParams;
__device__ __forceinline__ CParams* kernarg_params() {
  CParams* cp = (CParams*)__builtin_amdgcn_kernarg_segment_ptr();
  asm volatile("" : "+s"(cp));
  return cp;
}

template <int PH>
__device__ __forceinline__ void phase_seq(char* smem, volatile LAS unsigned* xbw) {
#ifdef __HIP_DEVICE_COMPILE__
  {
    const Params q = *kernarg_params();
    run_phase<PH>(q, smem, blockIdx.x, gridDim.x);
  }
  if constexpr (PH < NPHASES) {
    {
      XcdBarrier xb;
      xb.bar = kernarg_params()->BAR;
      xb.x = xb_xcc_id();
      xb.st = xbw;
      xcd_barrier(xb);
    }
    phase_seq<PH + 1>(smem, xbw);
  }
#endif
}

__global__ void __launch_bounds__(NTHREADS, 2) mk(Params p) {
  __shared__ __attribute__((aligned(16))) char smem[SMEM_BYTES];
  __shared__ uint4 xb_words;
#ifdef __HIP_DEVICE_COMPILE__
  if (tidx() == 0) xb_words = make_uint4(0u, 0u, 0u, 0u);
  __syncthreads();
  (void)xcd_barrier_post(kernarg_params()->BAR, (volatile LAS unsigned*)&xb_words);
  if (gridDim.x == 0x7fffffffu) cg::this_grid().sync();
  phase_seq<0>(smem, (volatile LAS unsigned*)&xb_words);
#endif
}
#else
template <int PH>
static void launch_seq(const Params& p, int grid_blocks, hipStream_t stream) {
  hipLaunchKernelGGL(mk1<PH>, dim3(grid_blocks), dim3(NTHREADS), 0, stream, p);
  if constexpr (PH < NPHASES) launch_seq<PH + 1>(p, grid_blocks, stream);
}

#endif

extern "C" void kernel_launch(void* const* d_in, const int* in_sizes, int n_in, void* d_out, int out_size, void* d_ws,
                              size_t ws_size, hipStream_t stream) {
  Params p;
  memset(&p, 0, sizeof(p));
  p.x = (const float*)d_in[0];
  p.attn_norm = (const float*)d_in[1];
  p.ffn_norm = (const float*)d_in[2];
  p.ev_w_in = (const float*)d_in[3];
  p.ev_ret_gn = (const float*)d_in[4];
  p.ev_w_o = (const float*)d_in[5];
  p.od_w_down = (const float*)d_in[6];
  p.od_q_norm = (const float*)d_in[7];
  p.od_w_uq = (const float*)d_in[8];
  p.od_kv_norm = (const float*)d_in[9];
  p.od_w_ukv = (const float*)d_in[10];
  p.od_w_o = (const float*)d_in[11];
  p.peer_wq = (const float*)d_in[12];
  p.peer_keys = (const float*)d_in[13];
  p.peer_u = (const float*)d_in[14];
  p.peer_v = (const float*)d_in[15];
  p.final_norm = (const float*)d_in[16];
  p.out = (float*)d_out;

  char* w = (char*)d_ws;
  size_t off = 0;
  auto take = [&](size_t bytes) {
    char* r = w + off;
    off += (bytes + 255) & ~(size_t)255;
    return r;
  };
  const size_t T = T_;
  p.WT_in = (bf16_t*)take(4608 * 1024 * 2);
  p.WT_o0 = (bf16_t*)take(1024 * 1536 * 2);
  p.WT_down = (bf16_t*)take(896 * 1024 * 2);
  p.WT_uq = (bf16_t*)take(1536 * 512 * 2);
  p.WT_ukv = (bf16_t*)take(2048 * 256 * 2);
  p.WT_o1 = (bf16_t*)take(1024 * 1024 * 2);
  p.WT_pq = (bf16_t*)take(2 * 1024 * 1024 * 2);
  p.PU8 = (unsigned char*)take(T * 1024);
  p.PV8 = (unsigned char*)take(T * 1024);
  p.PUS = (float*)take(T * 4);
  p.PKEYS = (bf16_t*)take(2 * 8 * 2 * 128 * 64 * 2);
  p.COSM = (float*)take(T * 8 * 4);
  p.SINM = (float*)take(T * 8 * 4);
  p.COSR = (float*)take(T * 32 * 4);
  p.SINR = (float*)take(T * 32 * 4);
  p.COSL = (float*)take(T * 16 * 4);
  p.SINL = (float*)take(T * 16 * 4);
  p.XN = (bf16_t*)take(T * 1024 * 2);
  p.EIDX = (int*)take(T * 128 * 4);
  p.GATE = (float*)take(T * 128 * 4);
  p.KMEAN = (float*)take(8 * 64 * 64 * 4);
  p.BAR = (unsigned*)take(XCD_BAR_WORDS * 4);
  p.GCNT = (unsigned*)take(512 * 4);
  p.SSQ0 = (float*)take(T * 16 * 4 * 4);
  p.SSQ1 = p.SSQ0 + T * 16;
  p.SSQQ = p.SSQ0 + 2 * T * 16;
  p.SSQKV = p.SSQ0 + 3 * T * 16;
  const size_t base = off;
  p.MQ = (bf16_t*)take(T * 512 * 2);
  p.MK = (bf16_t*)take(T * 512 * 2);
  p.MVT = (bf16_t*)take(T * 512 * 2);
  p.RQ = (bf16_t*)take(T * 512 * 2);
  p.RK = (bf16_t*)take(T * 512 * 2);
  p.RKTZ = (bf16_t*)take(T * 512 * 2);
  p.RVT = (bf16_t*)take(T * 1024 * 2);
  p.RG = (bf16_t*)take(T * 1024 * 2);
  p.CAT = (bf16_t*)take(T * 1536 * 2);
  p.SST = (float*)take((size_t)8 * 128 * 128 * 64 * 4);
  p.RT = (bf16_t*)take((size_t)8 * 128 * 128 * 64 * 2);
  p.MLIST = (unsigned*)take((size_t)512 * MOBA_LSTRIDE * 4);
  p.PO = (bf16_t*)take(T * 8 * 3 * 64 * 2);
  p.PML = (float*)take(T * 8 * 3 * 2 * 4);
  off = base;
  p.CQN = (bf16_t*)take(T * 512 * 2);
  p.CKVN = (bf16_t*)take(T * 256 * 2);
  p.Q1 = (bf16_t*)take(T * 1536 * 2);
  p.K1 = (bf16_t*)take(T * 1536 * 2);
  p.V1T = (bf16_t*)take(T * 1024 * 2);
  p.O1 = (bf16_t*)take(T * 1024 * 2);

  static int grid_blocks = 0;
  if (!grid_blocks) {
    int dev = 0, cus = 0, per_cu = 0;
    (void)hipGetDevice(&dev);
    (void)hipDeviceGetAttribute(&cus, hipDeviceAttributeMultiprocessorCount, dev);
#if MEGA
    (void)hipOccupancyMaxActiveBlocksPerMultiprocessor(&per_cu, mk, NTHREADS, 0);
#else
    per_cu = 2;
#endif
    if (per_cu > 2) per_cu = 2;
    if (per_cu < 1) per_cu = 1;
    grid_blocks = cus * per_cu;
  }
#if MEGA
  (void)hipMemsetAsync(p.BAR, 0, XCD_BAR_WORDS * 4, stream);
  void* args[] = {&p};
  hipError_t e = hipLaunchCooperativeKernel((void*)mk, dim3(grid_blocks), dim3(NTHREADS), args, 0, stream);
  if (e != hipSuccess) fprintf(stderr, "cooperative launch failed: %s (grid %d)\n", hipGetErrorString(e), grid_blocks);
#else
  launch_seq<0>(p, grid_blocks, stream);
#endif
}
```

```cpp
#include <hip/hip_runtime.h>
#include <hip/hip_cooperative_groups.h>
#include <cstdio>
#include <cstdint>
#include <cstring>
namespace cg = cooperative_groups;

#ifndef MEGA
#define MEGA 1
#endif

typedef unsigned short bf16_t;
typedef unsigned long long u64;

#define T_ 16384
#define DM 1024
#define EVEN_IN 4608
#define NTHREADS 256
#define MOBA_LSTRIDE 16384
#define ATT_THR 6.0f
#define MOBA_QSCALE (0.125f * 1.4426950408889634f)
#define MLA_QSCALE (0.10206207261596575f * 1.4426950408889634f)

__device__ __forceinline__ int tidx() {
  int t = __builtin_amdgcn_workitem_id_x();
  asm volatile("" : "+v"(t));
  return t;
}
__device__ __forceinline__ float bf2f(bf16_t b) { return __uint_as_float(((unsigned)b) << 16); }
__device__ __forceinline__ bf16_t f2bf(float f) {
  unsigned u = __float_as_uint(f);
  u += 0x7fffu + ((u >> 16) & 1u);
  return (bf16_t)(u >> 16);
}
typedef __attribute__((ext_vector_type(2))) float f32x2_t;
typedef __attribute__((ext_vector_type(2))) __bf16 bf16x2_t;
__device__ __forceinline__ unsigned pack2(float lo, float hi) {
  f32x2_t v = {lo, hi};
  bf16x2_t r = __builtin_convertvector(v, bf16x2_t);
  return __builtin_bit_cast(unsigned, r);
}
__device__ __forceinline__ float wave_sum(float v) {
#pragma unroll
  for (int o = 32; o > 0; o >>= 1) v += __shfl_xor(v, o);
  return v;
}
__device__ __forceinline__ float wave_max(float v) {
#pragma unroll
  for (int o = 32; o > 0; o >>= 1) v = fmaxf(v, __shfl_xor(v, o));
  return v;
}

struct Params {
  const float *x, *attn_norm, *ffn_norm, *ev_w_in, *ev_ret_gn, *ev_w_o, *od_w_down, *od_q_norm, *od_w_uq, *od_kv_norm,
      *od_w_ukv, *od_w_o, *peer_wq, *peer_keys, *peer_u, *peer_v, *final_norm;
  float* out;
  bf16_t *WT_in, *WT_o0, *WT_down, *WT_uq, *WT_ukv, *WT_o1, *WT_pq;
  bf16_t* PKEYS;
  unsigned char *PU8, *PV8;
  float* PUS;
  float *COSM, *SINM, *COSR, *SINR, *COSL, *SINL;
  bf16_t* XN;
  unsigned* BAR;
  unsigned *GCNT, *MLIST;
  float *SSQ0, *SSQ1, *SSQQ, *SSQKV;
  bf16_t* PO;
  float* PML;
  int* EIDX;
  float* GATE;
  bf16_t *MQ, *MK, *MVT, *RQ, *RK, *RKTZ, *RVT, *RG, *CAT, *RT;
  float* SST;
  float* KMEAN;
  bf16_t *CQN, *CKVN, *Q1, *K1, *V1T, *O1;
};

__device__ __forceinline__ void transpose_w(const float* __restrict__ src, int K, int N, bf16_t* __restrict__ dst, int Npad, float* tile,
                            int bid, int nb, const float* __restrict__ gk = nullptr) {
  const int tilesN = Npad / 32, tilesK = K / 32;
  const int c = tidx() & 31, r = tidx() >> 5;
  for (int it = bid; it < tilesN * tilesK; it += nb) {
    const int tn = it % tilesN, tk = it / tilesN;
#pragma unroll
    for (int i = 0; i < 4; i++) {
      const int k = tk * 32 + r + 8 * i, n = tn * 32 + c;
      tile[(r + 8 * i) * 33 + c] = (n < N) ? src[(size_t)k * N + n] * (gk ? gk[k] : 1.f) : 0.f;
    }
    __syncthreads();
#pragma unroll
    for (int i = 0; i < 4; i++) {
      const int n = tn * 32 + r + 8 * i, k = tk * 32 + c;
      dst[(size_t)n * K + k] = f2bf(tile[c * 33 + r + 8 * i]);
    }
    __syncthreads();
  }
}

__device__ __forceinline__ void convert_bf16(const float* __restrict__ src, bf16_t* __restrict__ dst, size_t n, int bid, int nb) {
  const size_t nvec = n / 8;
  for (size_t i = (size_t)bid * NTHREADS + tidx(); i < nvec; i += (size_t)nb * NTHREADS) {
    const float4 a = ((const float4*)src)[2 * i], b = ((const float4*)src)[2 * i + 1];
    uint4 o;
    o.x = pack2(a.x, a.y);
    o.y = pack2(a.z, a.w);
    o.z = pack2(b.x, b.y);
    o.w = pack2(b.z, b.w);
    ((uint4*)dst)[i] = o;
  }
}

__device__ __forceinline__ void rope_tables(float* cs, float* sn, int half, double theta, int bid, int nb) {
  const int total = T_ * half;
  for (int idx = bid * NTHREADS + tidx(); idx < total; idx += nb * NTHREADS) {
    const int t = idx / half, i = idx % half;
    const double inv = exp(-((double)i / (double)half) * log(theta));
    double rev = (double)t * inv * 0.15915494309189535;
    rev -= rint(rev);
    const float r = (float)(rev * 6.283185307179586);
    cs[idx] = __cosf(r);
    sn[idx] = __sinf(r);
  }
}

__device__ __forceinline__ void rmsnorm_rows(const float* __restrict__ in, const float* __restrict__ g, bf16_t* __restrict__ outb, int bid,
                             int nb, float* __restrict__ outf = nullptr) {
  const int lane = tidx() & 63, wid = tidx() >> 6;
  for (int row = bid * 4 + wid; row < T_; row += nb * 4) {
    const float* r = in + (size_t)row * DM;
    float4 v[4];
    float ss = 0.f;
#pragma unroll
    for (int j = 0; j < 4; j++) {
      v[j] = *(const float4*)(r + lane * 4 + 256 * j);
      ss += v[j].x * v[j].x + v[j].y * v[j].y + v[j].z * v[j].z + v[j].w * v[j].w;
    }
    ss = wave_sum(ss);
    const float sc = rsqrtf(ss * (1.f / DM) + 1e-6f);
#pragma unroll
    for (int j = 0; j < 4; j++) {
      const float4 gg = *(const float4*)(g + lane * 4 + 256 * j);
      uint2 o;
      o.x = pack2(v[j].x * sc * gg.x, v[j].y * sc * gg.y);
      o.y = pack2(v[j].z * sc * gg.z, v[j].w * sc * gg.w);
      *(uint2*)(outb + (size_t)row * DM + lane * 4 + 256 * j) = o;
      if (outf)
        *(float4*)(outf + (size_t)row * DM + lane * 4 + 256 * j) =
            make_float4(v[j].x * sc * gg.x, v[j].y * sc * gg.y, v[j].z * sc * gg.z, v[j].w * sc * gg.w);
    }
  }
}

typedef __attribute__((ext_vector_type(8))) short bf16x8;
typedef __attribute__((ext_vector_type(4))) float f32x4;
typedef __attribute__((ext_vector_type(16))) float f32x16;

#define GEMM_LDS_BYTES 65536

__device__ __forceinline__ float ret_log2g(int h);
__device__ __forceinline__ void store8bf(bf16_t* dst, const float* v) {
  uint4 o;
  o.x = pack2(v[0], v[1]); o.y = pack2(v[2], v[3]); o.z = pack2(v[4], v[5]); o.w = pack2(v[6], v[7]);
  *(uint4*)dst = o;
}
__device__ __forceinline__ void store8T(bf16_t* dst, int f0, int t, const float* v) {
#pragma unroll
  for (int j = 0; j < 8; j += 2) {
    const unsigned w = pack2(v[j], v[j + 1]);
    dst[(size_t)(f0 + j) * T_ + t] = (bf16_t)(w & 0xffffu);
    dst[(size_t)(f0 + j + 1) * T_ + t] = (bf16_t)(w >> 16);
  }
}

struct EpiInProj {
  bf16_t *MQ, *MK, *MVT, *RQ, *RK, *RKTZ, *RVT, *RG;
  const float *COSM, *SINM, *COSR, *SINR;
  static constexpr int NK = 5;
  __device__ __forceinline__ int kind(int nb) const {
    return (nb < 1024) ? 0 : (nb < 1536) ? 1 : (nb < 2560) ? 2 : (nb < 3584) ? 3 : 4;
  }
  template <int KD>
  __device__ __forceinline__ void tok(int t, int nb, int q, float* v0, float* v1) const {
    if constexpr (KD == 0) {
      float pr[8];
#pragma unroll
      for (int j = 0; j < 8; j++) pr[j] = __shfl_xor(v0[j], 16);
      if (q < 2) {
        const float4 c0 = *(const float4*)(COSM + t * 8), c1 = *(const float4*)(COSM + t * 8 + 4);
        const float4 s0 = *(const float4*)(SINM + t * 8), s1 = *(const float4*)(SINM + t * 8 + 4);
        const float cs[8] = {c0.x, c0.y, c0.z, c0.w, c1.x, c1.y, c1.z, c1.w};
        const float sn[8] = {s0.x, s0.y, s0.z, s0.w, s1.x, s1.y, s1.z, s1.w};
        const float sg = (q == 0) ? -1.f : 1.f;
#pragma unroll
        for (int j = 0; j < 8; j++) v0[j] = v0[j] * cs[j] + sg * pr[j] * sn[j];
      }
      if (nb < 512) {
#pragma unroll
        for (int j = 0; j < 8; j++) { v0[j] *= MOBA_QSCALE; v1[j] *= MOBA_QSCALE; }
        store8bf(MQ + (size_t)t * 512 + nb + 8 * q, v0);
        store8bf(MQ + (size_t)t * 512 + nb + 32 + 8 * q, v1);
      } else {
        store8bf(MK + (size_t)t * 512 + (nb - 512) + 8 * q, v0);
        store8bf(MK + (size_t)t * 512 + (nb - 512) + 32 + 8 * q, v1);
      }
    } else if constexpr (KD == 1) {
      store8T(MVT, nb - 1024 + 8 * q, t, v0);
      store8T(MVT, nb - 1024 + 32 + 8 * q, t, v1);
    } else if constexpr (KD == 2) {
      const float4 c0 = *(const float4*)(COSR + t * 32 + 8 * q), c1 = *(const float4*)(COSR + t * 32 + 8 * q + 4);
      const float4 s0 = *(const float4*)(SINR + t * 32 + 8 * q), s1 = *(const float4*)(SINR + t * 32 + 8 * q + 4);
      const float cs[8] = {c0.x, c0.y, c0.z, c0.w, c1.x, c1.y, c1.z, c1.w};
      const float sn[8] = {s0.x, s0.y, s0.z, s0.w, s1.x, s1.y, s1.z, s1.w};
      float a[8], b[8];
#pragma unroll
      for (int j = 0; j < 8; j++) {
        a[j] = v0[j] * cs[j] - v1[j] * sn[j];
        b[j] = v1[j] * cs[j] + v0[j] * sn[j];
      }
      if (nb < 2048) {
        store8bf(RQ + (size_t)t * 512 + (nb - 1536) + 8 * q, a);
        store8bf(RQ + (size_t)t * 512 + (nb - 1536) + 32 + 8 * q, b);
      } else {
        const int hh = (nb - 2048) >> 6;
        const float zeta = exp2f(ret_log2g(hh) * (float)(127 - (t & 127)));
#pragma unroll
        for (int j = 0; j < 8; j++) { a[j] *= 0.125f; b[j] *= 0.125f; }
        store8bf(RK + (size_t)t * 512 + (nb - 2048) + 8 * q, a);
        store8bf(RK + (size_t)t * 512 + (nb - 2048) + 32 + 8 * q, b);
#pragma unroll
        for (int j = 0; j < 8; j++) { a[j] *= zeta; b[j] *= zeta; }
        store8T(RKTZ, nb - 2048 + 8 * q, t, a);
        store8T(RKTZ, nb - 2048 + 32 + 8 * q, t, b);
      }
    } else if constexpr (KD == 3) {
      store8T(RVT, nb - 2560 + 8 * q, t, v0);
      store8T(RVT, nb - 2560 + 32 + 8 * q, t, v1);
    } else {
      store8bf(RG + (size_t)t * 1024 + (nb - 3584) + 8 * q, v0);
      store8bf(RG + (size_t)t * 1024 + (nb - 3584) + 32 + 8 * q, v1);
    }
  }
};

__device__ __forceinline__ void ssq_store(float* ssqp, int t, int slot, int q, float part) {
  part += __shfl_xor(part, 16);
  part += __shfl_xor(part, 32);
  if (q == 0) ssqp[(size_t)t * 16 + slot] = part;
}
template <int NSLOT>
__device__ __forceinline__ float ssq_sum(const float* ssqp, int t) {
  float s = 0.f;
#pragma unroll
  for (int i = 0; i < NSLOT; i += 4) {
    const float4 v = *(const float4*)(ssqp + (size_t)t * 16 + i);
    s += (v.x + v.y) + (v.z + v.w);
  }
  return s;
}
struct EpiUQ {
  bf16_t* Q1;
  const float *COSL, *SINL;
  const float* SSQQ;
  __device__ __forceinline__ void rope32(int t, int n32, int q, float* v) const {
    float pr[8];
#pragma unroll
    for (int j = 0; j < 8; j++) pr[j] = __shfl_xor(v[j], 32);
    if ((n32 >> 5) % 3 == 2) {
      const int i0 = (8 * q) & 15;
      const float4 c0 = *(const float4*)(COSL + t * 16 + i0), c1 = *(const float4*)(COSL + t * 16 + i0 + 4);
      const float4 s0 = *(const float4*)(SINL + t * 16 + i0), s1 = *(const float4*)(SINL + t * 16 + i0 + 4);
      const float cs[8] = {c0.x, c0.y, c0.z, c0.w, c1.x, c1.y, c1.z, c1.w};
      const float sn[8] = {s0.x, s0.y, s0.z, s0.w, s1.x, s1.y, s1.z, s1.w};
      const float sg = (q < 2) ? -1.f : 1.f;
#pragma unroll
      for (int j = 0; j < 8; j++) v[j] = v[j] * cs[j] + sg * pr[j] * sn[j];
    }
    const float sc = MLA_QSCALE * rsqrtf(ssq_sum<8>(SSQQ, t) * (1.f / 512.f) + 1e-6f);
#pragma unroll
    for (int j = 0; j < 8; j++) v[j] *= sc;
    store8bf(Q1 + (size_t)t * 1536 + n32 + 8 * q, v);
  }
  static constexpr int NK = 1;
  __device__ __forceinline__ int kind(int) const { return 0; }
  template <int KD>
  __device__ __forceinline__ void tok(int t, int nb, int q, float* v0, float* v1) const {
    rope32(t, nb, q, v0);
    rope32(t, nb + 32, q, v1);
  }
};

struct EpiUKV {
  bf16_t *K1, *V1T;
  const float* SSQKV;
  static constexpr int NK = 2;
  __device__ __forceinline__ int kind(int nb) const { return (nb >> 6) & 1; }
  template <int KD>
  __device__ __forceinline__ void tok(int t, int nb, int q, float* v0, float* v1) const {
    const int h = nb >> 7;
    const float sc = rsqrtf(ssq_sum<4>(SSQKV, t) * (1.f / 256.f) + 1e-6f);
#pragma unroll
    for (int j = 0; j < 8; j++) { v0[j] *= sc; v1[j] *= sc; }
    if constexpr (KD == 0) {
      store8bf(K1 + (size_t)t * 1536 + h * 96 + 8 * q, v0);
      store8bf(K1 + (size_t)t * 1536 + h * 96 + 32 + 8 * q, v1);
    } else {
      store8T(V1T, h * 64 + 8 * q, t, v0);
      store8T(V1T, h * 64 + 32 + 8 * q, t, v1);
    }
  }
};

struct EpiResSSQ {
  const float* res;
  float* out;
  bf16_t* hb;
  float* ssq;
  static constexpr int NK = 1;
  __device__ __forceinline__ int kind(int) const { return 0; }
  template <int KD>
  __device__ __forceinline__ void tok(int t, int nb, int q, float* v0, float* v1) const {
    const size_t o0 = (size_t)t * 1024 + nb + 8 * q, o1 = o0 + 32;
    const float4 a0 = *(const float4*)(res + o0), a1 = *(const float4*)(res + o0 + 4);
    const float4 b0 = *(const float4*)(res + o1), b1 = *(const float4*)(res + o1 + 4);
    v0[0] += a0.x; v0[1] += a0.y; v0[2] += a0.z; v0[3] += a0.w; v0[4] += a1.x; v0[5] += a1.y; v0[6] += a1.z; v0[7] += a1.w;
    v1[0] += b0.x; v1[1] += b0.y; v1[2] += b0.z; v1[3] += b0.w; v1[4] += b1.x; v1[5] += b1.y; v1[6] += b1.z; v1[7] += b1.w;
    *(float4*)(out + o0) = make_float4(v0[0], v0[1], v0[2], v0[3]);
    *(float4*)(out + o0 + 4) = make_float4(v0[4], v0[5], v0[6], v0[7]);
    *(float4*)(out + o1) = make_float4(v1[0], v1[1], v1[2], v1[3]);
    *(float4*)(out + o1 + 4) = make_float4(v1[4], v1[5], v1[6], v1[7]);
    store8bf(hb + o0, v0);
    store8bf(hb + o1, v1);
    float part = 0.f;
#pragma unroll
    for (int j = 0; j < 8; j++) part += v0[j] * v0[j] + v1[j] * v1[j];
    ssq_store(ssq, t, nb >> 6, q, part);
  }
};
struct EpiDown {
  bf16_t *CQN, *CKVN, *K1;
  float *SSQQ, *SSQKV;
  const float *COSL, *SINL;
  static constexpr int NK = 3;
  __device__ __forceinline__ int kind(int nb) const { return (nb < 512) ? 0 : (nb < 768) ? 1 : 2; }
  template <int KD>
  __device__ __forceinline__ void tok(int t, int nb, int q, float* v0, float* v1) const {
    if constexpr (KD == 0 || KD == 1) {
      bf16_t* dst = (KD == 0) ? (CQN + (size_t)t * 512 + nb) : (CKVN + (size_t)t * 256 + (nb - 512));
      store8bf(dst + 8 * q, v0);
      store8bf(dst + 32 + 8 * q, v1);
      float part = 0.f;
#pragma unroll
      for (int j = 0; j < 8; j++) part += v0[j] * v0[j] + v1[j] * v1[j];
      ssq_store((KD == 0) ? SSQQ : SSQKV, t, (KD == 0) ? (nb >> 6) : ((nb - 512) >> 6), q, part);
    } else {
      float pr[8];
#pragma unroll
      for (int j = 0; j < 8; j++) pr[j] = __shfl_xor(v0[j], 32);
      if (nb == 768) {
        const int i0 = (8 * q) & 15;
        const float4 c0 = *(const float4*)(COSL + t * 16 + i0), c1 = *(const float4*)(COSL + t * 16 + i0 + 4);
        const float4 s0 = *(const float4*)(SINL + t * 16 + i0), s1 = *(const float4*)(SINL + t * 16 + i0 + 4);
        const float cs[8] = {c0.x, c0.y, c0.z, c0.w, c1.x, c1.y, c1.z, c1.w};
        const float sn[8] = {s0.x, s0.y, s0.z, s0.w, s1.x, s1.y, s1.z, s1.w};
        const float sg = (q < 2) ? -1.f : 1.f;
        float o[8];
#pragma unroll
        for (int j = 0; j < 8; j++) o[j] = v0[j] * cs[j] + sg * pr[j] * sn[j];
        uint4 w;
        w.x = pack2(o[0], o[1]); w.y = pack2(o[2], o[3]); w.z = pack2(o[4], o[5]); w.w = pack2(o[6], o[7]);
#pragma unroll
        for (int hh = 0; hh < 16; hh++) *(uint4*)(K1 + (size_t)t * 1536 + hh * 96 + 64 + 8 * q) = w;
      }
    }
  }
};

__device__ __forceinline__ void route_unit(const Params& p, const bf16_t* keys, int h, int t0, const bf16_t* qrow,
                                           unsigned char* ltab);
#define RQ_STRIDE 136
struct EpiRoute {
  const Params* pp;
  const float* ssq;
  int layer;
  char* smem;
  static constexpr int NK = 1;
  static constexpr bool TILE_HOOK = true;
  __device__ __forceinline__ int kind(int) const { return 0; }
  template <int KD>
  __device__ __forceinline__ void tok(int t, int nb, int q, float* v0, float* v1) const {
    const float sc = rsqrtf(ssq_sum<16>(ssq, t) * (1.f / 1024.f) + 1e-6f);
#pragma unroll
    for (int j = 0; j < 8; j++) { v0[j] *= sc; v1[j] *= sc; }
    bf16_t* row = (bf16_t*)smem + (t & 127) * RQ_STRIDE + (nb & 127);
    store8bf(row + 8 * q, v0);
    store8bf(row + 32 + 8 * q, v1);
  }
  __device__ __forceinline__ void tile_hook(int m0, int n0) const {
    __syncthreads();
    const int lane = tidx() & 63, wid = tidx() >> 6;
    unsigned char* ltab = (unsigned char*)smem + 36864 + wid * 2048 + lane * 32;
    const bf16_t* keys = pp->PKEYS + (size_t)layer * 8 * 2 * 128 * 64;
    route_unit(*pp, keys, n0 >> 7, m0 + 32 * wid, (const bf16_t*)smem + (32 * wid + (lane & 31)) * RQ_STRIDE, ltab);
  }
};

template <class Epi, int KD>
__device__ __forceinline__ void gemm_epi_dispatch(const Epi& epi, int kd, f32x4 (&acc)[4][4], int tbase, int nb64, int q) {
  if (kd == KD) {
#pragma unroll
    for (int tb = 0; tb < 4; tb++) {
      const int t = tbase + tb * 16;
      float v0[8], v1[8];
      v0[0] = acc[tb][0][0]; v0[1] = acc[tb][0][1]; v0[2] = acc[tb][0][2]; v0[3] = acc[tb][0][3];
      v0[4] = acc[tb][1][0]; v0[5] = acc[tb][1][1]; v0[6] = acc[tb][1][2]; v0[7] = acc[tb][1][3];
      v1[0] = acc[tb][2][0]; v1[1] = acc[tb][2][1]; v1[2] = acc[tb][2][2]; v1[3] = acc[tb][2][3];
      v1[4] = acc[tb][3][0]; v1[5] = acc[tb][3][1]; v1[6] = acc[tb][3][2]; v1[7] = acc[tb][3][3];
      epi.template tok<KD>(t, nb64, q, v0, v1);
    }
  } else if constexpr (KD + 1 < Epi::NK) {
    gemm_epi_dispatch<Epi, KD + 1>(epi, kd, acc, tbase, nb64, q);
  }
}

__device__ __forceinline__ void glds16(const void* g, unsigned lds_base) {
  unsigned sv;
  asm volatile("s_mov_b32 %0, m0\n\ts_mov_b32 m0, %2\n\ts_nop 0\n\tglobal_load_lds_dwordx4 %1, off\n\ts_mov_b32 m0, %0"
               : "=&s"(sv)
               : "v"(g), "s"(lds_base)
               : "memory");
}

template <class T, class = void>
struct epi_has_hook { static constexpr bool value = false; };
template <class T>
struct epi_has_hook<T, decltype((void)T::TILE_HOOK)> { static constexpr bool value = true; };

template <class Epi>
__device__ __forceinline__ void gemm_mfma(const bf16_t* __restrict__ A, int lda, const bf16_t* __restrict__ W, int ldw, int M, int N, int K,
                          const Epi& epi, char* smem, int bid, int nb) {
  const int tid = tidx(), lane = tid & 63, wid = tid >> 6;
  const int wm = wid >> 1, wn = wid & 1;
  const int l15 = lane & 15, q = lane >> 4;
  const int srow0 = tid >> 3, sc = tid & 7;
  const int tilesN = N / 128, tiles = (M / 128) * tilesN, nk = K / 64;
  const int lrow = srow0, lpos = sc;
  const int wperm = (((lrow >> 2) & 3) << 3) | (((lrow >> 4) & 1) << 2) | (lrow & 3);
  const size_t aoff = (size_t)lrow * lda + ((lpos ^ (lrow & 7)) << 3);
  const size_t woff = (size_t)wperm * ldw + ((lpos ^ (lrow & 7)) << 3);
  const int wbase = __builtin_amdgcn_readfirstlane(wid) * 1024;
  const unsigned ldsb = (unsigned)(uintptr_t)smem;
#define STAGE(buf, AP, WP, kk)                                                                      \
  {                                                                                                 \
    const unsigned da_ = (unsigned)__builtin_amdgcn_readfirstlane((int)(ldsb + (buf) * 16384 + wbase));         \
    const unsigned db_ = da_ + 32768;                                                               \
    glds16((AP) + (kk), da_);                                                                       \
    glds16((AP) + (size_t)32 * lda + (kk), da_ + 4096);                                             \
    glds16((AP) + (size_t)64 * lda + (kk), da_ + 8192);                                             \
    glds16((AP) + (size_t)96 * lda + (kk), da_ + 12288);                                            \
    glds16((WP) + (kk), db_);                                                                       \
    glds16((WP) + (size_t)32 * ldw + (kk), db_ + 4096);                                             \
    glds16((WP) + (size_t)64 * ldw + (kk), db_ + 8192);                                             \
    glds16((WP) + (size_t)96 * ldw + (kk), db_ + 12288);                                            \
  }
  constexpr bool PREF = !epi_has_hook<Epi>::value;
  bool staged = false;
  for (int tile = bid; tile < tiles; tile += nb) {
    const int m0 = (tile / tilesN) * 128, n0 = (tile % tilesN) * 128;
    f32x4 acc[4][4];
#pragma unroll
    for (int i = 0; i < 4; i++)
#pragma unroll
      for (int j = 0; j < 4; j++) acc[i][j] = (f32x4){0.f, 0.f, 0.f, 0.f};
    const bf16_t* Ag = A + (size_t)m0 * lda + aoff;
    const bf16_t* Wg = W + (size_t)n0 * ldw + woff;
    const int tile2 = tile + nb;
    const bool has2 = PREF && tile2 < tiles;
    const bf16_t* Ag2 = A + (size_t)((has2 ? tile2 : tile) / tilesN) * 128 * lda + aoff;
    const bf16_t* Wg2 = W + (size_t)((has2 ? tile2 : tile) % tilesN) * 128 * ldw + woff;
    if (!staged) {
      __syncthreads();
      STAGE(0, Ag, Wg, 0);
    }
    asm volatile("s_waitcnt vmcnt(0) lgkmcnt(0)\n\ts_barrier" ::: "memory");
    for (int kt = 0; kt < nk; kt++) {
      const int cur = kt & 1;
      if (kt + 1 < nk) { STAGE(cur ^ 1, Ag, Wg, (kt + 1) * 64); }
      else if (has2) { STAGE(0, Ag2, Wg2, 0); }
      const char* sA = smem + cur * 16384;
      const char* sB = smem + 32768 + cur * 16384;
#pragma unroll
      for (int s = 0; s < 2; s++) {
        const int c = 4 * s + q;
        const int xr = wm * 64 + l15, wr = wn * 64 + l15;
        const char* xa = sA + xr * 128 + ((c ^ (xr & 7)) << 4);
        const char* wa = sB + wr * 128 + ((c ^ (wr & 7)) << 4);
        const bf16x8 xf0 = *(const bf16x8*)(xa), xf1 = *(const bf16x8*)(xa + 2048), xf2 = *(const bf16x8*)(xa + 4096),
                     xf3 = *(const bf16x8*)(xa + 6144);
        const bf16x8 wf0 = *(const bf16x8*)(wa), wf1 = *(const bf16x8*)(wa + 2048), wf2 = *(const bf16x8*)(wa + 4096),
                     wf3 = *(const bf16x8*)(wa + 6144);
#define MM(tb, fb, xf, wf) acc[tb][fb] = __builtin_amdgcn_mfma_f32_16x16x32_bf16(wf, xf, acc[tb][fb], 0, 0, 0)
        MM(0, 0, xf0, wf0); MM(0, 1, xf0, wf1); MM(0, 2, xf0, wf2); MM(0, 3, xf0, wf3);
        MM(1, 0, xf1, wf0); MM(1, 1, xf1, wf1); MM(1, 2, xf1, wf2); MM(1, 3, xf1, wf3);
        MM(2, 0, xf2, wf0); MM(2, 1, xf2, wf1); MM(2, 2, xf2, wf2); MM(2, 3, xf2, wf3);
        MM(3, 0, xf3, wf0); MM(3, 1, xf3, wf1); MM(3, 2, xf3, wf2); MM(3, 3, xf3, wf3);
#undef MM
      }
      if (kt + 1 < nk) asm volatile("s_waitcnt vmcnt(0) lgkmcnt(0)\n\ts_barrier" ::: "memory");
      else asm volatile("s_waitcnt lgkmcnt(0)\n\ts_barrier" ::: "memory");
    }
    staged = has2;
    gemm_epi_dispatch<Epi, 0>(epi, epi.kind(n0 + wn * 64), acc, m0 + wm * 64 + l15, n0 + wn * 64, q);
    if constexpr (epi_has_hook<Epi>::value) epi.tile_hook(m0, n0);
  }
#undef STAGE
}


__device__ __forceinline__ float ret_log2g(int h);
__device__ __forceinline__ void moba_kmean(const Params& p, int bid, int nb) {
  for (int idx = bid * NTHREADS + tidx(); idx < 8 * 64 * 64; idx += nb * NTHREADS) {
    const int d = idx & 63, blk = (idx >> 6) & 63, h = idx >> 12;
    float s = 0.f;
    for (int j = 0; j < 256; j++) s += bf2f(p.MK[(size_t)(blk * 256 + j) * 512 + h * 64 + d]);
    p.KMEAN[idx] = s * (1.f / 256.f);
  }
}

__device__ __forceinline__ void moba_select(const Params& p, char* smem, int bid, int nb) {
  const int tid = tidx();
  int* lcnt = (int*)smem;
  int* lbase = (int*)smem + 64;
  for (int it = bid; it < 8 * 64; it += nb) {
    const int h = it >> 6, blk = it & 63;
    const int t = blk * 256 + tid;
    float q[64];
    const uint4* qp = (const uint4*)(p.MQ + (size_t)t * 512 + h * 64);
#pragma unroll
    for (int c = 0; c < 8; c++) {
      const uint4 u = qp[c];
      q[c * 8 + 0] = __uint_as_float(u.x << 16); q[c * 8 + 1] = __uint_as_float(u.x & 0xffff0000u);
      q[c * 8 + 2] = __uint_as_float(u.y << 16); q[c * 8 + 3] = __uint_as_float(u.y & 0xffff0000u);
      q[c * 8 + 4] = __uint_as_float(u.z << 16); q[c * 8 + 5] = __uint_as_float(u.z & 0xffff0000u);
      q[c * 8 + 6] = __uint_as_float(u.w << 16); q[c * 8 + 7] = __uint_as_float(u.w & 0xffff0000u);
    }
    float v1 = -INFINITY, v2 = -INFINITY, v3 = -INFINITY;
    int i1 = -1, i2 = -1, i3 = -1;
    for (int j = 0; j < blk; j++) {
      const float* km = p.KMEAN + ((size_t)h * 64 + j) * 64;
      float g = 0.f;
#pragma unroll
      for (int d = 0; d < 64; d++) g += q[d] * km[d];
      if (g > v1) { v3 = v2; i3 = i2; v2 = v1; i2 = i1; v1 = g; i1 = j; }
      else if (g > v2) { v3 = v2; i3 = i2; v2 = g; i2 = j; }
      else if (g > v3) { v3 = g; i3 = j; }
    }
    if (tid < 64) lcnt[tid] = 0;
    __syncthreads();
    int p1 = 0, p2 = 0, p3 = 0;
    if (i1 >= 0) p1 = atomicAdd(&lcnt[i1], 1);
    if (i2 >= 0) p2 = atomicAdd(&lcnt[i2], 1);
    if (i3 >= 0) p3 = atomicAdd(&lcnt[i3], 1);
    __syncthreads();
    if (tid < 64) {
      const int c = lcnt[tid];
      if (c > 0) lbase[tid] = (int)atomicAdd(&p.GCNT[h * 64 + tid], (unsigned)c);
    }
    __syncthreads();
    if (i1 >= 0) p.MLIST[(size_t)(h * 64 + i1) * MOBA_LSTRIDE + lbase[i1] + p1] = ((unsigned)t << 2) | 0u;
    if (i2 >= 0) p.MLIST[(size_t)(h * 64 + i2) * MOBA_LSTRIDE + lbase[i2] + p2] = ((unsigned)t << 2) | 1u;
    if (i3 >= 0) p.MLIST[(size_t)(h * 64 + i3) * MOBA_LSTRIDE + lbase[i3] + p3] = ((unsigned)t << 2) | 2u;
    __syncthreads();
  }
}

template <int DQ, bool CAUSAL>
__device__ __forceinline__ void attn_tile(const char* kb, const char* vb, const bf16x8 (&qf)[DQ / 16], f32x16& o0, f32x16& o1,
                                          float& m, float& lsum, int j, bool first, int q0, int qg, int hi,
                                          const int (&koff)[DQ / 16], const int (&voff)[4]) {
  constexpr int KS = DQ / 16;
  const bool active = CAUSAL ? (j * 64 <= q0 + 31) : true;
  if (active) {
    f32x16 s0, s1;
    const float negm = -m;
#pragma unroll
    for (int r = 0; r < 16; r++) { s0[r] = negm; s1[r] = negm; }
#pragma unroll
    for (int s = 0; s < KS; s++) {
      const bf16x8 k0 = *(const bf16x8*)(kb + koff[s]);
      const bf16x8 k1 = *(const bf16x8*)(kb + koff[s] + 32 * (DQ * 2));
      s0 = __builtin_amdgcn_mfma_f32_32x32x16_bf16(k0, qf[s], s0, 0, 0, 0);
      s1 = __builtin_amdgcn_mfma_f32_32x32x16_bf16(k1, qf[s], s1, 0, 0, 0);
    }
    if (CAUSAL && (j * 64 + 63 > q0)) {
      const int kv0 = j * 64 + 8 * hi;
#pragma unroll
      for (int r = 0; r < 16; r++) {
        const int kva = kv0 + 16 * (r >> 3) + (r & 7);
        s0[r] = (kva <= qg) ? s0[r] : -INFINITY;
        s1[r] = (kva + 32 <= qg) ? s1[r] : -INFINITY;
      }
    }
    float mx = s0[0];
#pragma unroll
    for (int r = 1; r < 16; r++) mx = fmaxf(mx, s0[r]);
#pragma unroll
    for (int r = 0; r < 16; r++) mx = fmaxf(mx, s1[r]);
    {
      typedef __attribute__((ext_vector_type(2))) unsigned u32x2_t;
      const u32x2_t sw = __builtin_amdgcn_permlane32_swap(__float_as_uint(mx), __float_as_uint(mx), false, false);
      mx = fmaxf(__uint_as_float(sw[0]), __uint_as_float(sw[1]));
    }
    if (first || __any(mx > ATT_THR)) {
      const float d = first ? mx : ((mx > ATT_THR) ? mx : 0.f);
      const float alpha = __builtin_amdgcn_exp2f(-d);
      m += d;
      lsum *= alpha;
#pragma unroll
      for (int r = 0; r < 16; r++) {
        o0[r] *= alpha; o1[r] *= alpha;
        s0[r] -= d; s1[r] -= d;
      }
    }
    float ps = 0.f;
#pragma unroll
    for (int r = 0; r < 16; r++) {
      s0[r] = __builtin_amdgcn_exp2f(s0[r]);
      s1[r] = __builtin_amdgcn_exp2f(s1[r]);
      ps += s0[r] + s1[r];
    }
    lsum += ps;
    bf16x8 pb[4];
    {
      typedef __attribute__((ext_vector_type(4))) unsigned u32x4;
      u32x4 t0, t1, t2, t3;
      t0[0] = pack2(s0[0], s0[1]); t0[1] = pack2(s0[2], s0[3]); t0[2] = pack2(s0[4], s0[5]); t0[3] = pack2(s0[6], s0[7]);
      t1[0] = pack2(s0[8], s0[9]); t1[1] = pack2(s0[10], s0[11]); t1[2] = pack2(s0[12], s0[13]); t1[3] = pack2(s0[14], s0[15]);
      t2[0] = pack2(s1[0], s1[1]); t2[1] = pack2(s1[2], s1[3]); t2[2] = pack2(s1[4], s1[5]); t2[3] = pack2(s1[6], s1[7]);
      t3[0] = pack2(s1[8], s1[9]); t3[1] = pack2(s1[10], s1[11]); t3[2] = pack2(s1[12], s1[13]); t3[3] = pack2(s1[14], s1[15]);
      pb[0] = __builtin_bit_cast(bf16x8, t0);
      pb[1] = __builtin_bit_cast(bf16x8, t1);
      pb[2] = __builtin_bit_cast(bf16x8, t2);
      pb[3] = __builtin_bit_cast(bf16x8, t3);
    }
#pragma unroll
    for (int ks = 0; ks < 4; ks++) {
      const bf16x8 v0 = *(const bf16x8*)(vb + voff[ks]);
      const bf16x8 v1 = *(const bf16x8*)(vb + voff[ks] + 32 * 128);
      o0 = __builtin_amdgcn_mfma_f32_32x32x16_bf16(v0, pb[ks], o0, 0, 0, 0);
      o1 = __builtin_amdgcn_mfma_f32_32x32x16_bf16(v1, pb[ks], o1, 0, 0, 0);
    }
  }
}

#define PINV(x) asm volatile("" : "+v"(x))
#define ATT_PTHR 256.f
template <int DQ, bool MASK>
__device__ __forceinline__ void attn_tile3(const char* kb, const char* vb, const bf16x8 (&qf)[DQ / 16], f32x16& o0, f32x16& o1,
                                           float& m, float& lsum, f32x16& negm, int j, int qg, int hi,
                                           const int (&koff)[DQ / 16], const int (&voff)[4]) {
  constexpr int KS = DQ / 16;
  f32x16 s0, s1;
#pragma unroll
  for (int s = 0; s < KS; s++) {
    const bf16x8 k0 = *(const bf16x8*)(kb + koff[s]);
    const bf16x8 k1 = *(const bf16x8*)(kb + koff[s] + 32 * (DQ * 2));
    if (s == 0) {
      s0 = __builtin_amdgcn_mfma_f32_32x32x16_bf16(k0, qf[0], negm, 0, 0, 0);
      s1 = __builtin_amdgcn_mfma_f32_32x32x16_bf16(k1, qf[0], negm, 0, 0, 0);
    } else {
      s0 = __builtin_amdgcn_mfma_f32_32x32x16_bf16(k0, qf[s], s0, 0, 0, 0);
      s1 = __builtin_amdgcn_mfma_f32_32x32x16_bf16(k1, qf[s], s1, 0, 0, 0);
    }
  }
  if (MASK) {
    const int kv0 = j * 64 + 8 * hi;
#pragma unroll
    for (int r = 0; r < 16; r++) {
      const int kva = kv0 + 16 * (r >> 3) + (r & 7);
      s0[r] = (kva <= qg) ? s0[r] : -INFINITY;
      s1[r] = (kva + 32 <= qg) ? s1[r] : -INFINITY;
    }
  }
  float psA = 0.f, psB = 0.f;
#pragma unroll
  for (int r = 0; r < 16; r++) {
    s0[r] = __builtin_amdgcn_exp2f(s0[r]);
    s1[r] = __builtin_amdgcn_exp2f(s1[r]);
  }
#pragma unroll
  for (int r = 0; r < 16; r++) { psA += s0[r]; psB += s1[r]; }
  bf16x8 pb[4];
  {
    typedef __attribute__((ext_vector_type(4))) unsigned u32x4;
    u32x4 t0, t1, t2, t3;
    t0[0] = pack2(s0[0], s0[1]); t0[1] = pack2(s0[2], s0[3]); t0[2] = pack2(s0[4], s0[5]); t0[3] = pack2(s0[6], s0[7]);
    t1[0] = pack2(s0[8], s0[9]); t1[1] = pack2(s0[10], s0[11]); t1[2] = pack2(s0[12], s0[13]); t1[3] = pack2(s0[14], s0[15]);
    t2[0] = pack2(s1[0], s1[1]); t2[1] = pack2(s1[2], s1[3]); t2[2] = pack2(s1[4], s1[5]); t2[3] = pack2(s1[6], s1[7]);
    t3[0] = pack2(s1[8], s1[9]); t3[1] = pack2(s1[10], s1[11]); t3[2] = pack2(s1[12], s1[13]); t3[3] = pack2(s1[14], s1[15]);
    pb[0] = __builtin_bit_cast(bf16x8, t0);
    pb[1] = __builtin_bit_cast(bf16x8, t1);
    pb[2] = __builtin_bit_cast(bf16x8, t2);
    pb[3] = __builtin_bit_cast(bf16x8, t3);
  }
#pragma unroll
  for (int ks = 0; ks < 4; ks++) {
    const bf16x8 v0 = *(const bf16x8*)(vb + voff[ks]);
    const bf16x8 v1 = *(const bf16x8*)(vb + voff[ks] + 32 * 128);
    o0 = __builtin_amdgcn_mfma_f32_32x32x16_bf16(v0, pb[ks], o0, 0, 0, 0);
    o1 = __builtin_amdgcn_mfma_f32_32x32x16_bf16(v1, pb[ks], o1, 0, 0, 0);
  }
  const float ps = psA + psB;
  lsum += ps;
  float pt;
  {
    typedef __attribute__((ext_vector_type(2))) unsigned u32x2_t;
    const u32x2_t sw = __builtin_amdgcn_permlane32_swap(__float_as_uint(ps), __float_as_uint(ps), false, false);
    pt = __uint_as_float(sw[0]) + __uint_as_float(sw[1]);
  }
  if (__any(pt > ATT_PTHR)) {
    const float d = (pt > ATT_PTHR) ? __log2f(pt) : 0.f;
    const float alpha = __builtin_amdgcn_exp2f(-d);
    m += d;
    lsum *= alpha;
    const float nm = -m;
#pragma unroll
    for (int r = 0; r < 16; r++) { o0[r] *= alpha; o1[r] *= alpha; negm[r] = nm; }
    PINV(negm);
  }
}

template <int CPR>
__device__ __forceinline__ int attn_swz(int c, int row) {
  if constexpr (CPR == 12) return (c & ~3) | ((c & 3) ^ ((row >> 2) & 3));
  else return c ^ ((row >> 1) & 7);
}
template <int DQ, bool CAUSAL>
__device__ __forceinline__ void attn_core(const bf16_t* __restrict__ Q, const bf16_t* __restrict__ Kp,
                                          const bf16_t* __restrict__ VT, int H, int h, int qg, int q0, int jlo, int jhi,
                                          char* smem, f32x16& o0, f32x16& o1, float& m, float& lsum) {
  constexpr int KS = DQ / 16;
  constexpr int CPR = DQ / 8;
  constexpr int KPW = CPR / 4;
  constexpr int KBYTES = CPR * 1024;
  constexpr int SLOT = KBYTES + 8192;
  static_assert(3 * SLOT <= 61440, "attention ring");
  const int tid = tidx(), lane = tid & 63;
  const int wid = __builtin_amdgcn_readfirstlane(tid >> 6);
  const int l31 = lane & 31, hi = lane >> 5;
  const int ldq = H * DQ;
  const int sig = (l31 & 19) | ((l31 & 4) << 1) | ((l31 & 8) >> 1);
  const unsigned lds0 = (unsigned)(uintptr_t)smem;
  int koff[KS], voff[4];
#pragma unroll
  for (int s = 0; s < KS; s++) koff[s] = sig * (DQ * 2) + attn_swz<CPR>(2 * s + hi, sig) * 16;
#pragma unroll
  for (int ks = 0; ks < 4; ks++) voff[ks] = l31 * 128 + attn_swz<8>(2 * ks + hi, l31) * 16;
  const bf16_t* kg0; const bf16_t* kg1; const bf16_t* kg2; const bf16_t* vg0; const bf16_t* vg1;
  {
    const int id0 = wid * 64 + lane, id1 = id0 + 256, id2 = id0 + 512;
    const int r0 = id0 / CPR, r1 = id1 / CPR, r2 = id2 / CPR;
    kg0 = Kp + (size_t)r0 * ldq + h * DQ + attn_swz<CPR>(id0 % CPR, r0) * 8;
    kg1 = Kp + (size_t)r1 * ldq + h * DQ + attn_swz<CPR>(id1 % CPR, r1) * 8;
    kg2 = Kp + (size_t)r2 * ldq + h * DQ + attn_swz<CPR>(id2 % CPR, r2) * 8;
    const int vr0 = id0 >> 3, vr1 = id1 >> 3;
    vg0 = VT + ((size_t)h * 64 + vr0) * T_ + attn_swz<8>(id0 & 7, vr0) * 8;
    vg1 = VT + ((size_t)h * 64 + vr1) * T_ + attn_swz<8>(id1 & 7, vr1) * 8;
  }
#define DMA_TILE(j, slotoff)                                                                                         \
  {                                                                                                                  \
    const size_t ko_ = (size_t)(j) * 64 * ldq;                                                                       \
    const unsigned kd_ = (unsigned)__builtin_amdgcn_readfirstlane((int)(lds0 + (slotoff) + wid * 1024));            \
    glds16(kg0 + ko_, kd_);                                                                                          \
    glds16(kg1 + ko_, kd_ + 4096);                                                                                   \
    if constexpr (KPW > 2) glds16(kg2 + ko_, kd_ + 8192);                                                            \
    glds16(vg0 + (j) * 64, kd_ + KBYTES);                                                                            \
    glds16(vg1 + (j) * 64, kd_ + KBYTES + 4096);                                                                     \
  }
#define WAIT_BAR_NP() { if constexpr (KPW > 2) asm volatile("s_waitcnt vmcnt(5) lgkmcnt(0)\n\ts_barrier" ::: "memory"); \
                        else asm volatile("s_waitcnt vmcnt(4) lgkmcnt(0)\n\ts_barrier" ::: "memory"); }
#define WAIT_BAR_0() asm volatile("s_waitcnt vmcnt(0) lgkmcnt(0)\n\ts_barrier" ::: "memory")
  bf16x8 qf[KS];
#pragma unroll
  for (int s = 0; s < KS; s++) qf[s] = *(const bf16x8*)(Q + (size_t)qg * ldq + h * DQ + 16 * s + 8 * hi);
#pragma unroll
  for (int s = 0; s < KS; s++) PINV(qf[s]);
#pragma unroll
  for (int r = 0; r < 16; r++) { o0[r] = 0.f; o1[r] = 0.f; }
  m = 0.f;
  lsum = 0.f;
  f32x16 negm;
#pragma unroll
  for (int r = 0; r < 16; r++) negm[r] = 0.f;
  __syncthreads();
  DMA_TILE(jlo, 0);
  if (jlo + 1 <= jhi) { DMA_TILE(jlo + 1, SLOT); WAIT_BAR_NP(); } else { WAIT_BAR_0(); }
  int j = jlo;
  int s_cur = 0, s_n1 = SLOT, s_n2 = 2 * SLOT;
  if (j + 2 <= jhi) DMA_TILE(j + 2, s_n2);
  attn_tile<DQ, CAUSAL>(smem + s_cur, smem + s_cur + KBYTES, qf, o0, o1, m, lsum, j, true, q0, qg, hi, koff, voff);
  {
    const float nm = -m;
#pragma unroll
    for (int r = 0; r < 16; r++) negm[r] = nm;
    PINV(negm);
  }
  if (j + 2 <= jhi) { WAIT_BAR_NP(); } else { WAIT_BAR_0(); }
  ++j;
  while (j <= jhi) {
    { const int t_ = s_cur; s_cur = s_n1; s_n1 = s_n2; s_n2 = t_; }
    if (j + 2 <= jhi) DMA_TILE(j + 2, s_n2);
    if (CAUSAL && (j * 64 + 63 > q0)) attn_tile3<DQ, true>(smem + s_cur, smem + s_cur + KBYTES, qf, o0, o1, m, lsum, negm, j, qg, hi, koff, voff);
    else attn_tile3<DQ, false>(smem + s_cur, smem + s_cur + KBYTES, qf, o0, o1, m, lsum, negm, j, qg, hi, koff, voff);
    if (j + 2 <= jhi) { WAIT_BAR_NP(); } else { WAIT_BAR_0(); }
    ++j;
  }
#undef DMA_TILE
#undef WAIT_BAR_NP
#undef WAIT_BAR_0
}

__device__ __forceinline__ void attn_store_rows(bf16_t* op, const f32x16& o0, const f32x16& o1, float inv) {
#pragma unroll
  for (int rg = 0; rg < 4; rg++) {
    uint2 w0, w1;
    w0.x = pack2(o0[4 * rg] * inv, o0[4 * rg + 1] * inv);
    w0.y = pack2(o0[4 * rg + 2] * inv, o0[4 * rg + 3] * inv);
    w1.x = pack2(o1[4 * rg] * inv, o1[4 * rg + 1] * inv);
    w1.y = pack2(o1[4 * rg + 2] * inv, o1[4 * rg + 3] * inv);
    *(uint2*)(op + 8 * rg) = w0;
    *(uint2*)(op + 32 + 8 * rg) = w1;
  }
}

template <int DQ>
__device__ __forceinline__ void attn_causal(const bf16_t* __restrict__ Q, const bf16_t* __restrict__ Kp,
                                            const bf16_t* __restrict__ VT, bf16_t* __restrict__ O, int ldo, int H, char* smem,
                                            int bid, int nb) {
  const int lane = tidx() & 63, wid = tidx() >> 6;
  const int l31 = lane & 31, hi = lane >> 5;
  const int xcd = bid & 7, local = bid >> 3, nloc = nb >> 3;
  for (int idx = local; idx < 64 * (H >> 3); idx += nloc) {
    const int h = xcd + 8 * (idx >> 6), pi = idx & 63;
    for (int half = 0; half < 2; half++) {
      const int qt = half ? (127 - pi) : pi;
      const int q0 = qt * 128 + wid * 32;
      const int qg = q0 + l31;
      f32x16 o0, o1;
      float m, lsum;
      attn_core<DQ, true>(Q, Kp, VT, H, h, qg, q0, 0, 2 * qt + 1, smem, o0, o1, m, lsum);
      const float ltot = lsum + __shfl_xor(lsum, 32);
      attn_store_rows(O + (size_t)qg * ldo + h * 64 + 4 * hi, o0, o1, 1.f / ltot);
    }
  }
}

__device__ __forceinline__ void moba_gathered(const Params& p, char* smem, int bid, int nb) {
  const int tid = tidx(), lane = tid & 63, wid = tid >> 6;
  const int l31 = lane & 31, hi = lane >> 5;
  int* pre = (int*)(smem + 49152);
  {
    const int c0 = (int)((p.GCNT[2 * tid] + 127u) >> 7), c1 = (int)((p.GCNT[2 * tid + 1] + 127u) >> 7);
    int sc = c0 + c1;
#pragma unroll
    for (int o = 1; o < 64; o <<= 1) {
      const int v = __shfl_up(sc, o);
      if (lane >= o) sc += v;
    }
    int* wsum = pre + 520;
    if (lane == 63) wsum[wid] = sc;
    __syncthreads();
    int off = 0;
    for (int w = 0; w < wid; w++) off += wsum[w];
    const int incl = sc + off;
    pre[2 * tid] = incl - c0 - c1;
    pre[2 * tid + 1] = incl - c1;
    if (tid == 255) pre[512] = incl;
    __syncthreads();
  }
  const int total = pre[512];
  for (int c = bid; c < total; c += nb) {
    int lo = 0, hi_ = 512;
    while (hi_ - lo > 1) {
      const int mid = (lo + hi_) >> 1;
      if (pre[mid] <= c) lo = mid; else hi_ = mid;
    }
    const int k = __builtin_amdgcn_readfirstlane(lo);
    const int h = k >> 6, jb = k & 63;
    const int cnt = (int)p.GCNT[k];
    const int e = (c - pre[k]) * 128 + wid * 32 + l31;
    const bool valid = e < cnt;
    const unsigned ent = p.MLIST[(size_t)k * MOBA_LSTRIDE + (valid ? e : 0)];
    const int tq = (int)(ent >> 2), r = (int)(ent & 3u);
    f32x16 o0, o1;
    float m, lsum;
    attn_core<64, false>(p.MQ, p.MK, p.MVT, 8, h, tq, 0, 4 * jb, 4 * jb + 3, smem, o0, o1, m, lsum);
    const float ltot = lsum + __shfl_xor(lsum, 32);
    if (valid) {
      const size_t slot = ((size_t)tq * 8 + h) * 3 + r;
      attn_store_rows(p.PO + slot * 64 + 4 * hi, o0, o1, 1.f / ltot);
      if (hi == 0) *(float2*)(p.PML + slot * 2) = make_float2(m, ltot);
    }
  }
}

__device__ __forceinline__ void moba_own_merge(const Params& p, char* smem, int bid, int nb) {
  const int lane = tidx() & 63, wid = tidx() >> 6;
  const int l31 = lane & 31, hi = lane >> 5;
  const int xcd = bid & 7, local = bid >> 3, nloc = nb >> 3;
  for (int idx = local; idx < 64; idx += nloc) {
    const int h = xcd, pi = idx & 63;
    for (int half = 0; half < 2; half++) {
      const int qt = half ? (127 - pi) : pi;
      const int q0 = qt * 128 + wid * 32;
      const int qg = q0 + l31;
      const int blk = qt >> 1;
      f32x16 o0, o1;
      float m, lsum;
      attn_core<64, true>(p.MQ, p.MK, p.MVT, 8, h, qg, q0, 4 * blk, 2 * qt + 1, smem, o0, o1, m, lsum);
      float l = lsum + __shfl_xor(lsum, 32);
      const int nsel = blk < 3 ? blk : 3;
      const size_t slot0 = ((size_t)qg * 8 + h) * 3;
      float2 st0 = *(const float2*)(p.PML + (slot0 + 0) * 2), st1 = *(const float2*)(p.PML + (slot0 + 1) * 2),
             st2 = *(const float2*)(p.PML + (slot0 + 2) * 2);
      uint2 pa[3][4], pq[3][4];
#pragma unroll
      for (int rr = 0; rr < 3; rr++) {
        const bf16_t* pp = p.PO + (slot0 + rr) * 64 + 4 * hi;
#pragma unroll
        for (int rg = 0; rg < 4; rg++) { pa[rr][rg] = *(const uint2*)(pp + 8 * rg); pq[rr][rg] = *(const uint2*)(pp + 32 + 8 * rg); }
      }
      const float pm0 = nsel > 0 ? st0.x : -1e30f, pl0 = nsel > 0 ? st0.y : 0.f;
      const float pm1 = nsel > 1 ? st1.x : -1e30f, pl1 = nsel > 1 ? st1.y : 0.f;
      const float pm2 = nsel > 2 ? st2.x : -1e30f, pl2 = nsel > 2 ? st2.y : 0.f;
      const float M = fmaxf(fmaxf(m, pm0), fmaxf(pm1, pm2));
      const float w = __builtin_amdgcn_exp2f(m - M);
      const float w0 = pl0 * __builtin_amdgcn_exp2f(pm0 - M), w1 = pl1 * __builtin_amdgcn_exp2f(pm1 - M),
                  w2 = pl2 * __builtin_amdgcn_exp2f(pm2 - M);
      const float L = l * w + w0 + w1 + w2;
#pragma unroll
      for (int r = 0; r < 16; r++) { o0[r] *= w; o1[r] *= w; }
#pragma unroll
      for (int rr = 0; rr < 3; rr++) {
        const float wr = rr == 0 ? w0 : (rr == 1 ? w1 : w2);
        const unsigned vm = (unsigned)-(int)(rr < nsel);
#pragma unroll
        for (int rg = 0; rg < 4; rg++) {
          const unsigned ax = pa[rr][rg].x & vm, ay = pa[rr][rg].y & vm, bx = pq[rr][rg].x & vm, by = pq[rr][rg].y & vm;
          o0[4 * rg] += wr * __uint_as_float(ax << 16); o0[4 * rg + 1] += wr * __uint_as_float(ax & 0xffff0000u);
          o0[4 * rg + 2] += wr * __uint_as_float(ay << 16); o0[4 * rg + 3] += wr * __uint_as_float(ay & 0xffff0000u);
          o1[4 * rg] += wr * __uint_as_float(bx << 16); o1[4 * rg + 1] += wr * __uint_as_float(bx & 0xffff0000u);
          o1[4 * rg + 2] += wr * __uint_as_float(by << 16); o1[4 * rg + 3] += wr * __uint_as_float(by & 0xffff0000u);
        }
      }
      attn_store_rows(p.CAT + (size_t)qg * 1536 + h * 64 + 4 * hi, o0, o1, 1.f / L);
    }
  }
}

__device__ __forceinline__ float ret_log2g(int h) { return log2f(1.f - exp2f(-5.f - (float)h)); }

__device__ __forceinline__ void retention_state(const Params& p, int bid, int nb) {
  const int lane = tidx() & 63, wid = tidx() >> 6;
  const int l31 = lane & 31, hi = lane >> 5;
  for (int it = bid * 4 + wid; it < 8 * 128 * 4; it += nb * 4) {
    const int eb = it & 3, i = (it >> 2) & 127, h = it >> 9;
    const bf16_t* kt = p.RKTZ + ((size_t)h * 64 + l31) * T_ + i * 128 + 8 * hi;
    const bf16_t* vt = p.RVT + ((size_t)h * 128 + eb * 32 + l31) * T_ + i * 128 + 8 * hi;
    f32x16 a0, a1;
#pragma unroll
    for (int r = 0; r < 16; r++) { a0[r] = 0.f; a1[r] = 0.f; }
#pragma unroll
    for (int s = 0; s < 8; s++) {
      const bf16x8 k0 = *(const bf16x8*)(kt + 16 * s);
      const bf16x8 k1 = *(const bf16x8*)(kt + (size_t)32 * T_ + 16 * s);
      const bf16x8 vf = *(const bf16x8*)(vt + 16 * s);
      a0 = __builtin_amdgcn_mfma_f32_32x32x16_bf16(k0, vf, a0, 0, 0, 0);
      a1 = __builtin_amdgcn_mfma_f32_32x32x16_bf16(k1, vf, a1, 0, 0, 0);
    }
    float* sp = p.SST + (((size_t)h * 128 + i) * 128 + eb * 32 + l31) * 64 + 4 * hi;
#pragma unroll
    for (int rg = 0; rg < 4; rg++) {
      *(float4*)(sp + 8 * rg) = make_float4(a0[4 * rg], a0[4 * rg + 1], a0[4 * rg + 2], a0[4 * rg + 3]);
      *(float4*)(sp + 32 + 8 * rg) = make_float4(a1[4 * rg], a1[4 * rg + 1], a1[4 * rg + 2], a1[4 * rg + 3]);
    }
  }
}

__device__ __forceinline__ void retention_prefix(const Params& p, int bid, int nb) {
  for (int idx = bid * NTHREADS + tidx(); idx < 8 * 128 * 64; idx += nb * NTHREADS) {
    const int h = idx >> 13, ed = idx & 8191;
    const float g128 = exp2f(128.f * ret_log2g(h));
    float R = 0.f;
    const float* sp = p.SST + (size_t)h * 128 * 8192 + ed;
    bf16_t* rp = p.RT + (size_t)h * 128 * 8192 + ed;
#pragma unroll 8
    for (int i = 0; i < 128; i++) {
      rp[(size_t)i * 8192] = f2bf(R);
      R = g128 * R + sp[(size_t)i * 8192];
    }
  }
}

__device__ __forceinline__ void retention_out(const Params& p, char* smem, int bid, int nb) {
  constexpr int KSTR = 144, VSTR = 272, KBYTES = 128 * KSTR;
  const int tid = tidx(), lane = tid & 63, w = tid >> 6;
  const int l31 = lane & 31, hi = lane >> 5;
  const int sig = (l31 & 19) | ((l31 & 4) << 1) | ((l31 & 8) >> 1);
  char* sK = smem;
  char* sV = smem + KBYTES;
  for (int it = bid; it < 8 * 128; it += nb) {
    const int i = it & 127, h = it >> 7;
    const int t0 = i * 128;
    const int nl = 32 * w + l31;
    const float lg = ret_log2g(h);
    bf16x8 qf[4];
#pragma unroll
    for (int s = 0; s < 4; s++) qf[s] = *(const bf16x8*)(p.RQ + (size_t)(t0 + nl) * 512 + h * 64 + 16 * s + 8 * hi);
    uint4 rr0, rr1, rr2, rr3;
    {
      const bf16_t* rg_ = p.RT + (((size_t)h * 128 + i) * 128 + (tid >> 3)) * 64 + (tid & 7) * 8;
      rr0 = *(const uint4*)(rg_); rr1 = *(const uint4*)(rg_ + 32 * 64); rr2 = *(const uint4*)(rg_ + 64 * 64); rr3 = *(const uint4*)(rg_ + 96 * 64);
    }
    const size_t t = (size_t)(t0 + nl);
    uint2 ga[4], gb[4], gc[4], gd[4];
#pragma unroll
    for (int rg = 0; rg < 4; rg++) {
      const bf16_t* gp = p.RG + t * 1024 + h * 128 + 8 * rg + 4 * hi;
      ga[rg] = *(const uint2*)(gp); gb[rg] = *(const uint2*)(gp + 32); gc[rg] = *(const uint2*)(gp + 64); gd[rg] = *(const uint2*)(gp + 96);
    }
    {
      uint4 kr0, kr1, kr2, kr3, vr0, vr1, vr2, vr3, vr4, vr5, vr6, vr7;
      const bf16_t* kg = p.RK + (size_t)(t0 + (tid >> 3)) * 512 + h * 64 + (tid & 7) * 8;
      const bf16_t* vg = p.RVT + ((size_t)h * 128 + (tid >> 4)) * T_ + t0 + (tid & 15) * 8;
      kr0 = *(const uint4*)(kg); kr1 = *(const uint4*)(kg + (size_t)32 * 512);
      kr2 = *(const uint4*)(kg + (size_t)64 * 512); kr3 = *(const uint4*)(kg + (size_t)96 * 512);
      vr0 = *(const uint4*)(vg); vr1 = *(const uint4*)(vg + (size_t)16 * T_);
      vr2 = *(const uint4*)(vg + (size_t)32 * T_); vr3 = *(const uint4*)(vg + (size_t)48 * T_);
      vr4 = *(const uint4*)(vg + (size_t)64 * T_); vr5 = *(const uint4*)(vg + (size_t)80 * T_);
      vr6 = *(const uint4*)(vg + (size_t)96 * T_); vr7 = *(const uint4*)(vg + (size_t)112 * T_);
      __syncthreads();
      char* kd = sK + (tid >> 3) * KSTR + (tid & 7) * 16;
      *(uint4*)(kd) = kr0; *(uint4*)(kd + 32 * KSTR) = kr1; *(uint4*)(kd + 64 * KSTR) = kr2; *(uint4*)(kd + 96 * KSTR) = kr3;
      char* vd = sV + (tid >> 4) * VSTR + (tid & 15) * 16;
      *(uint4*)(vd) = vr0; *(uint4*)(vd + 16 * VSTR) = vr1; *(uint4*)(vd + 32 * VSTR) = vr2; *(uint4*)(vd + 48 * VSTR) = vr3;
      *(uint4*)(vd + 64 * VSTR) = vr4; *(uint4*)(vd + 80 * VSTR) = vr5; *(uint4*)(vd + 96 * VSTR) = vr6; *(uint4*)(vd + 112 * VSTR) = vr7;
    }
    __syncthreads();
    bf16x8 pb[8];
#pragma unroll
    for (int mb = 0; mb < 4; mb++) {
      if (mb <= w) {
        f32x16 sc;
#pragma unroll
        for (int r = 0; r < 16; r++) sc[r] = 0.f;
        const char* kp = sK + (32 * mb + sig) * KSTR + hi * 16;
#pragma unroll
        for (int s = 0; s < 4; s++) {
          const bf16x8 kf = *(const bf16x8*)(kp + 32 * s);
          sc = __builtin_amdgcn_mfma_f32_32x32x16_bf16(kf, qf[s], sc, 0, 0, 0);
        }
#pragma unroll
        for (int r = 0; r < 16; r++) {
          const int ml = 32 * mb + 16 * (r >> 3) + 8 * hi + (r & 7);
          const int df = nl - ml;
          sc[r] = (df >= 0) ? sc[r] * exp2f(lg * (float)df) : 0.f;
        }
        typedef __attribute__((ext_vector_type(4))) unsigned u32x4;
        u32x4 t0v, t1v;
        t0v[0] = pack2(sc[0], sc[1]); t0v[1] = pack2(sc[2], sc[3]); t0v[2] = pack2(sc[4], sc[5]); t0v[3] = pack2(sc[6], sc[7]);
        t1v[0] = pack2(sc[8], sc[9]); t1v[1] = pack2(sc[10], sc[11]); t1v[2] = pack2(sc[12], sc[13]); t1v[3] = pack2(sc[14], sc[15]);
        pb[2 * mb] = __builtin_bit_cast(bf16x8, t0v);
        pb[2 * mb + 1] = __builtin_bit_cast(bf16x8, t1v);
      } else {
        pb[2 * mb] = (bf16x8){0, 0, 0, 0, 0, 0, 0, 0};
        pb[2 * mb + 1] = (bf16x8){0, 0, 0, 0, 0, 0, 0, 0};
      }
    }
    __syncthreads();
    {
      char* rd = sK + (tid >> 3) * KSTR + (tid & 7) * 16;
      *(uint4*)(rd) = rr0; *(uint4*)(rd + 32 * KSTR) = rr1; *(uint4*)(rd + 64 * KSTR) = rr2; *(uint4*)(rd + 96 * KSTR) = rr3;
    }
    __syncthreads();
    const float xi = exp2f(lg * (float)(nl + 1));
    float sum = 0.f, sumsq = 0.f, mu = 0.f, rs = 0.f;
#pragma unroll 1
    for (int pass = 0; pass < 2; pass++) {
#pragma unroll 1
      for (int eb = 0; eb < 4; eb++) {
        f32x16 a1, a2;
#pragma unroll
        for (int r = 0; r < 16; r++) { a1[r] = 0.f; a2[r] = 0.f; }
        const char* vt = sV + (eb * 32 + l31) * VSTR + hi * 16;
#pragma unroll
        for (int ks = 0; ks < 8; ks++) {
          if ((ks >> 1) <= w) {
            const bf16x8 vf = *(const bf16x8*)(vt + 32 * ks);
            a1 = __builtin_amdgcn_mfma_f32_32x32x16_bf16(vf, pb[ks], a1, 0, 0, 0);
          }
        }
        const char* rt = sK + (eb * 32 + l31) * KSTR + hi * 16;
#pragma unroll
        for (int s = 0; s < 4; s++) {
          const bf16x8 rf = *(const bf16x8*)(rt + 32 * s);
          a2 = __builtin_amdgcn_mfma_f32_32x32x16_bf16(rf, qf[s], a2, 0, 0, 0);
        }
        if (pass == 0) {
#pragma unroll
          for (int r = 0; r < 16; r++) {
            const float v = a1[r] + xi * a2[r];
            sum += v;
            sumsq += v * v;
          }
        } else {
#pragma unroll
          for (int rg = 0; rg < 4; rg++) {
            const int e = 32 * eb + 8 * rg + 4 * hi;
            const float4 gn = *(const float4*)(p.ev_ret_gn + h * 128 + e);
            const unsigned m0_ = (unsigned)-(int)(eb == 0), m1_ = (unsigned)-(int)(eb == 1), m2_ = (unsigned)-(int)(eb == 2), m3_ = (unsigned)-(int)(eb == 3);
            uint2 gr;
            gr.x = (ga[rg].x & m0_) | (gb[rg].x & m1_) | (gc[rg].x & m2_) | (gd[rg].x & m3_);
            gr.y = (ga[rg].y & m0_) | (gb[rg].y & m1_) | (gc[rg].y & m2_) | (gd[rg].y & m3_);
            const float g0 = __uint_as_float(gr.x << 16), g1 = __uint_as_float(gr.x & 0xffff0000u);
            const float g2 = __uint_as_float(gr.y << 16), g3 = __uint_as_float(gr.y & 0xffff0000u);
            const float s0 = g0 / (1.f + __expf(-g0)), s1 = g1 / (1.f + __expf(-g1));
            const float s2 = g2 / (1.f + __expf(-g2)), s3 = g3 / (1.f + __expf(-g3));
            const float v0 = a1[4 * rg] + xi * a2[4 * rg], v1 = a1[4 * rg + 1] + xi * a2[4 * rg + 1];
            const float v2 = a1[4 * rg + 2] + xi * a2[4 * rg + 2], v3 = a1[4 * rg + 3] + xi * a2[4 * rg + 3];
            uint2 o;
            o.x = pack2((v0 - mu) * rs * gn.x * s0, (v1 - mu) * rs * gn.y * s1);
            o.y = pack2((v2 - mu) * rs * gn.z * s2, (v3 - mu) * rs * gn.w * s3);
            *(uint2*)(p.CAT + t * 1536 + 512 + h * 128 + e) = o;
          }
        }
      }
      if (pass == 0) {
        sum += __shfl_xor(sum, 32);
        sumsq += __shfl_xor(sumsq, 32);
        mu = sum * (1.f / 128.f);
        const float var = fmaxf(sumsq * (1.f / 128.f) - mu * mu, 0.f);
        rs = rsqrtf(var + 1e-6f);
      }
    }
  }
}


#define CE_DESC(x, y) { const float mx_ = fmaxf(x, y), mn_ = fminf(x, y); x = mx_; y = mn_; }

template <int N>
__device__ __forceinline__ void bitonic_sort_desc(float (&a)[N]) {
#pragma unroll
  for (int k = 2; k <= N; k <<= 1)
#pragma unroll
    for (int j = k >> 1; j > 0; j >>= 1)
#pragma unroll
      for (int i = 0; i < N; i++) {
        const int l = i ^ j;
        if (l > i) {
          const float mx = fmaxf(a[i], a[l]), mn = fminf(a[i], a[l]);
          if ((i & k) == 0) { a[i] = mx; a[l] = mn; }
          else { a[i] = mn; a[l] = mx; }
        }
      }
}
__device__ __forceinline__ void merge_top16(float (&a)[16], const float (&b)[16]) {
#pragma unroll
  for (int i = 0; i < 16; i++) a[i] = fmaxf(a[i], b[15 - i]);
#pragma unroll
  for (int j = 8; j > 0; j >>= 1)
#pragma unroll
    for (int i = 0; i < 16; i++) {
      const int l = i ^ j;
      if (l > i) CE_DESC(a[i], a[l]);
    }
}
__device__ __forceinline__ float pack_low(float v, unsigned mask, unsigned bits) {
  return __uint_as_float((__float_as_uint(v) & ~mask) | bits);
}

__device__ __forceinline__ void route_unit(const Params& p, const bf16_t* keys, int h, int t0, const bf16_t* qrow,
                                           unsigned char* ltab) {
  const int lane = tidx() & 63;
  const int l31 = lane & 31, hi = lane >> 5;
  {
    const int t = t0 + l31;
    float top[2][16];
#pragma unroll
    for (int pp = 0; pp < 2; pp++) {
      bf16x8 qf[4];
#pragma unroll
      for (int s = 0; s < 4; s++) qf[s] = *(const bf16x8*)(qrow + pp * 64 + 16 * s + 8 * hi);
      float v[4][16];
#pragma unroll
      for (int nbk = 0; nbk < 4; nbk++) {
        f32x16 acc;
#pragma unroll
        for (int r = 0; r < 16; r++) acc[r] = 0.f;
        const bf16_t* kp = keys + (((size_t)h * 2 + pp) * 128 + nbk * 32 + l31) * 64 + 8 * hi;
#pragma unroll
        for (int s = 0; s < 4; s++) {
          const bf16x8 kf = *(const bf16x8*)(kp + 16 * s);
          acc = __builtin_amdgcn_mfma_f32_32x32x16_bf16(kf, qf[s], acc, 0, 0, 0);
        }
#pragma unroll
        for (int r = 0; r < 16; r++)
          v[nbk][r] = pack_low(acc[r], 127u, (unsigned)(32 * nbk + (r & 3) + 8 * (r >> 2) + 4 * hi));
        bitonic_sort_desc<16>(v[nbk]);
      }
      merge_top16(v[0], v[1]);
      merge_top16(v[2], v[3]);
      merge_top16(v[0], v[2]);
      float o[16];
#pragma unroll
      for (int i = 0; i < 16; i++) o[i] = __shfl_xor(v[0][i], 32);
      merge_top16(v[0], o);
#pragma unroll
      for (int i = 0; i < 16; i++) top[pp][i] = v[0][i];
    }
    {
      unsigned w[8];
#pragma unroll
      for (int k = 0; k < 8; k++) {
        const int pp = k >> 2, i0 = (k & 3) * 4;
        w[k] = (__float_as_uint(top[pp][i0]) & 127u) | ((__float_as_uint(top[pp][i0 + 1]) & 127u) << 8) |
               ((__float_as_uint(top[pp][i0 + 2]) & 127u) << 16) | ((__float_as_uint(top[pp][i0 + 3]) & 127u) << 24);
      }
      *(uint4*)(ltab) = make_uint4(w[0], w[1], w[2], w[3]);
      *(uint4*)(ltab + 16) = make_uint4(w[4], w[5], w[6], w[7]);
    }
#define CAND(a, b) pack_low(top[0][a] + top[1][b], 255u, (unsigned)(((a) << 4) | (b)))
    const float NEG = -INFINITY;
    float g0[16], g1[16], g2[16], g3[16];
#pragma unroll
    for (int b = 0; b < 16; b++) g0[b] = CAND(0, b);
#pragma unroll
    for (int b = 0; b < 8; b++) g1[b] = CAND(1, b);
    g1[8] = CAND(6, 0); g1[9] = CAND(6, 1); g1[10] = CAND(7, 0); g1[11] = CAND(7, 1);
    g1[12] = NEG; g1[13] = NEG; g1[14] = NEG; g1[15] = NEG;
    g2[0] = CAND(2, 0); g2[1] = CAND(2, 1); g2[2] = CAND(2, 2); g2[3] = CAND(2, 3); g2[4] = CAND(2, 4);
    g2[5] = CAND(3, 0); g2[6] = CAND(3, 1); g2[7] = CAND(3, 2); g2[8] = CAND(3, 3);
    g2[9] = CAND(4, 0); g2[10] = CAND(4, 1); g2[11] = CAND(4, 2);
    g2[12] = CAND(5, 0); g2[13] = CAND(5, 1); g2[14] = NEG; g2[15] = NEG;
#pragma unroll
    for (int a = 8; a < 16; a++) g3[a - 8] = CAND(a, 0);
#pragma unroll
    for (int i = 8; i < 16; i++) g3[i] = NEG;
#undef CAND
    bitonic_sort_desc<16>(g1);
    bitonic_sort_desc<16>(g2);
    merge_top16(g0, g1);
    merge_top16(g2, g3);
    merge_top16(g0, g2);
    float e[16], sum = 0.f;
#pragma unroll
    for (int r = 0; r < 16; r++) {
      e[r] = __expf(g0[r] - g0[0]);
      sum += e[r];
    }
    const float inv = 1.f / sum;
    int id[8];
    float gt[8];
#pragma unroll
    for (int r = 0; r < 8; r++) {
      const unsigned hm = (unsigned)(-hi);
      const float gv = __uint_as_float((__float_as_uint(g0[8 + r]) & hm) | (__float_as_uint(g0[r]) & ~hm));
      const float ev = __uint_as_float((__float_as_uint(e[8 + r]) & hm) | (__float_as_uint(e[r]) & ~hm));
      const unsigned ab = __float_as_uint(gv) & 255u;
      const int i1 = ltab[ab >> 4], i2 = ltab[16 + (ab & 15u)];
      id[r] = i1 * 128 + i2;
      gt[r] = ev * inv;
    }
    int* ep = p.EIDX + (size_t)t * 128 + h * 16 + 8 * hi;
    float* gp = p.GATE + (size_t)t * 128 + h * 16 + 8 * hi;
    *(int4*)ep = make_int4(id[0], id[1], id[2], id[3]);
    *(int4*)(ep + 4) = make_int4(id[4], id[5], id[6], id[7]);
    *(float4*)gp = make_float4(gt[0], gt[1], gt[2], gt[3]);
    *(float4*)(gp + 4) = make_float4(gt[4], gt[5], gt[6], gt[7]);
  }
}

__device__ __forceinline__ void unpack8(const uint4 u, float* f) {
  f[0] = __uint_as_float(u.x << 16); f[1] = __uint_as_float(u.x & 0xffff0000u);
  f[2] = __uint_as_float(u.y << 16); f[3] = __uint_as_float(u.y & 0xffff0000u);
  f[4] = __uint_as_float(u.z << 16); f[5] = __uint_as_float(u.z & 0xffff0000u);
  f[6] = __uint_as_float(u.w << 16); f[7] = __uint_as_float(u.w & 0xffff0000u);
}

#define PU_SCALE 64.f
#define PV_SCALE 8.f
typedef __attribute__((ext_vector_type(2))) float f32x2v;

__device__ __forceinline__ void convert_fp8(const float* __restrict__ src, unsigned char* __restrict__ dst, size_t n, float scale,
                                            int bid, int nb) {
  const size_t nvec = n / 16;
  for (size_t i = (size_t)bid * NTHREADS + tidx(); i < nvec; i += (size_t)nb * NTHREADS) {
    const float4* sp = (const float4*)src + 4 * i;
    const float4 a = sp[0], b = sp[1], c = sp[2], d = sp[3];
    int w0 = 0, w1 = 0, w2 = 0, w3 = 0;
    w0 = __builtin_amdgcn_cvt_pk_fp8_f32(a.x * scale, a.y * scale, w0, false);
    w0 = __builtin_amdgcn_cvt_pk_fp8_f32(a.z * scale, a.w * scale, w0, true);
    w1 = __builtin_amdgcn_cvt_pk_fp8_f32(b.x * scale, b.y * scale, w1, false);
    w1 = __builtin_amdgcn_cvt_pk_fp8_f32(b.z * scale, b.w * scale, w1, true);
    w2 = __builtin_amdgcn_cvt_pk_fp8_f32(c.x * scale, c.y * scale, w2, false);
    w2 = __builtin_amdgcn_cvt_pk_fp8_f32(c.z * scale, c.w * scale, w2, true);
    w3 = __builtin_amdgcn_cvt_pk_fp8_f32(d.x * scale, d.y * scale, w3, false);
    w3 = __builtin_amdgcn_cvt_pk_fp8_f32(d.z * scale, d.w * scale, w3, true);
    ((int4*)dst)[i] = make_int4(w0, w1, w2, w3);
  }
}

__device__ __forceinline__ unsigned pack4_i8(float a, float b, float c, float d, float inv) {
  const int qa = __float2int_rn(a * inv), qb = __float2int_rn(b * inv), qc = __float2int_rn(c * inv), qd = __float2int_rn(d * inv);
  return (unsigned)(qa & 255) | ((unsigned)(qb & 255) << 8) | ((unsigned)(qc & 255) << 16) | ((unsigned)qd << 24);
}
__device__ __forceinline__ void convert_i8_rows(const float* __restrict__ src, unsigned char* __restrict__ dst,
                                                float* __restrict__ scales, int nrows, int bid, int nb) {
  const int lane = tidx() & 63, wid = tidx() >> 6;
  for (int row = bid * 4 + wid; row < nrows; row += nb * 4) {
    const float4* sp = (const float4*)(src + (size_t)row * 1024 + lane * 16);
    const float4 a = sp[0], b = sp[1], c = sp[2], d = sp[3];
    float mx = fmaxf(fmaxf(fmaxf(fabsf(a.x), fabsf(a.y)), fmaxf(fabsf(a.z), fabsf(a.w))),
                     fmaxf(fmaxf(fabsf(b.x), fabsf(b.y)), fmaxf(fabsf(b.z), fabsf(b.w))));
    mx = fmaxf(mx, fmaxf(fmaxf(fmaxf(fabsf(c.x), fabsf(c.y)), fmaxf(fabsf(c.z), fabsf(c.w))),
                         fmaxf(fmaxf(fabsf(d.x), fabsf(d.y)), fmaxf(fabsf(d.z), fabsf(d.w)))));
    mx = wave_max(mx);
    const float inv = mx > 0.f ? 127.f / mx : 0.f;
    uint4 w;
    w.x = pack4_i8(a.x, a.y, a.z, a.w, inv);
    w.y = pack4_i8(b.x, b.y, b.z, b.w, inv);
    w.z = pack4_i8(c.x, c.y, c.z, c.w, inv);
    w.w = pack4_i8(d.x, d.y, d.z, d.w, inv);
    *(uint4*)(dst + (size_t)row * 1024 + lane * 16) = w;
    if (lane == 0) scales[row] = mx * (1.f / 127.f);
  }
}
__device__ __forceinline__ float dot16_i8(const uint4 r, const uint4 x) {
  int s = __builtin_amdgcn_sdot4((int)r.x, (int)x.x, 0, false);
  s = __builtin_amdgcn_sdot4((int)r.y, (int)x.y, s, false);
  s = __builtin_amdgcn_sdot4((int)r.z, (int)x.z, s, false);
  s = __builtin_amdgcn_sdot4((int)r.w, (int)x.w, s, false);
  return (float)s;
}

__device__ __forceinline__ void convert_q4_rows(const float* __restrict__ src, unsigned char* __restrict__ dst, int nrows, int bid, int nb) {
  const int lane = tidx() & 63, wid = tidx() >> 6;
  for (int row = bid * 4 + wid; row < nrows; row += nb * 4) {
    const float4* sp = (const float4*)(src + (size_t)row * 1024 + lane * 16);
    const float4 a = sp[0], b = sp[1], c = sp[2], d = sp[3];
    const float v[16] = {a.x, a.y, a.z, a.w, b.x, b.y, b.z, b.w, c.x, c.y, c.z, c.w, d.x, d.y, d.z, d.w};
    float mx = 0.f;
#pragma unroll
    for (int i = 0; i < 16; i++) mx = fmaxf(mx, fabsf(v[i]));
    const float inv = mx > 0.f ? 7.f / mx : 0.f;
    unsigned n0 = 0u, n1 = 0u;
#pragma unroll
    for (int i = 0; i < 8; i++) {
      n0 |= ((unsigned)__float2int_rn(v[i] * inv) & 15u) << (4 * i);
      n1 |= ((unsigned)__float2int_rn(v[8 + i] * inv) & 15u) << (4 * i);
    }
    unsigned* dp = (unsigned*)(dst + (size_t)row * 768 + lane * 12);
    dp[0] = n0; dp[1] = n1; dp[2] = __float_as_uint(mx * (1.f / 7.f));
  }
}
__device__ __forceinline__ float dot16_q4(const uint3 r, const uint2 x, float sxl) {
  int sacc = __builtin_amdgcn_sdot8((int)r.x, (int)x.x, 0, false);
  sacc = __builtin_amdgcn_sdot8((int)r.y, (int)x.y, sacc, false);
  return (float)sacc * (__uint_as_float(r.z) * sxl);
}

__device__ __forceinline__ float dot16_fp8(const uint4 r, const f32x2v* x) {
  const f32x2v a0 = __builtin_amdgcn_cvt_pk_f32_fp8((int)r.x, false), a1 = __builtin_amdgcn_cvt_pk_f32_fp8((int)r.x, true);
  const f32x2v b0 = __builtin_amdgcn_cvt_pk_f32_fp8((int)r.y, false), b1 = __builtin_amdgcn_cvt_pk_f32_fp8((int)r.y, true);
  const f32x2v c0 = __builtin_amdgcn_cvt_pk_f32_fp8((int)r.z, false), c1 = __builtin_amdgcn_cvt_pk_f32_fp8((int)r.z, true);
  const f32x2v d0 = __builtin_amdgcn_cvt_pk_f32_fp8((int)r.w, false), d1 = __builtin_amdgcn_cvt_pk_f32_fp8((int)r.w, true);
  f32x2v s = a0 * x[0];
  f32x2v t = a1 * x[1];
  s = __builtin_elementwise_fma(b0, x[2], s);
  t = __builtin_elementwise_fma(b1, x[3], t);
  s = __builtin_elementwise_fma(c0, x[4], s);
  t = __builtin_elementwise_fma(c1, x[5], t);
  s = __builtin_elementwise_fma(d0, x[6], s);
  t = __builtin_elementwise_fma(d1, x[7], t);
  s += t;
  return s[0] + s[1];
}
__device__ __forceinline__ void axpy16_fp8(const uint4 r, float a, f32x2v* acc) {
  const f32x2v a0 = __builtin_amdgcn_cvt_pk_f32_fp8((int)r.x, false), a1 = __builtin_amdgcn_cvt_pk_f32_fp8((int)r.x, true);
  const f32x2v b0 = __builtin_amdgcn_cvt_pk_f32_fp8((int)r.y, false), b1 = __builtin_amdgcn_cvt_pk_f32_fp8((int)r.y, true);
  const f32x2v c0 = __builtin_amdgcn_cvt_pk_f32_fp8((int)r.z, false), c1 = __builtin_amdgcn_cvt_pk_f32_fp8((int)r.z, true);
  const f32x2v d0 = __builtin_amdgcn_cvt_pk_f32_fp8((int)r.w, false), d1 = __builtin_amdgcn_cvt_pk_f32_fp8((int)r.w, true);
  const f32x2v av = {a, a};
  acc[0] = __builtin_elementwise_fma(av, a0, acc[0]);
  acc[1] = __builtin_elementwise_fma(av, a1, acc[1]);
  acc[2] = __builtin_elementwise_fma(av, b0, acc[2]);
  acc[3] = __builtin_elementwise_fma(av, b1, acc[3]);
  acc[4] = __builtin_elementwise_fma(av, c0, acc[4]);
  acc[5] = __builtin_elementwise_fma(av, c1, acc[5]);
  acc[6] = __builtin_elementwise_fma(av, d0, acc[6]);
  acc[7] = __builtin_elementwise_fma(av, d1, acc[7]);
}
#define DPP_F(v, ctrl) __int_as_float(__builtin_amdgcn_update_dpp(0, __float_as_int(v), ctrl, 0xf, 0xf, false))
#define SWZ_F(v, pat) __int_as_float(__builtin_amdgcn_ds_swizzle(__float_as_int(v), pat))
#define RDL_F(v, l) __int_as_float(__builtin_amdgcn_readlane(__float_as_int(v), l))

__device__ __forceinline__ unsigned fp4_code(float v, float inv) {
  const float y = fabsf(v) * inv;
  const unsigned idx = (unsigned)(y > 0.25f) + (unsigned)(y > 0.75f) + (unsigned)(y > 1.25f) + (unsigned)(y > 1.75f) +
                       (unsigned)(y > 2.5f) + (unsigned)(y > 3.5f) + (unsigned)(y > 5.0f);
  return idx | ((v < 0.f) ? 8u : 0u);
}
__device__ __forceinline__ void convert_fp4_rows(const float* __restrict__ src, unsigned char* __restrict__ dst, int nrows, int bid, int nb) {
  const int lane = tidx() & 63, wid = tidx() >> 6;
  for (int row = bid * 4 + wid; row < nrows; row += nb * 4) {
    const float4* sp = (const float4*)(src + (size_t)row * 1024 + lane * 16);
    const float4 a = sp[0], b = sp[1], c = sp[2], d = sp[3];
    const float v[16] = {a.x, a.y, a.z, a.w, b.x, b.y, b.z, b.w, c.x, c.y, c.z, c.w, d.x, d.y, d.z, d.w};
    float mx = 0.f;
#pragma unroll
    for (int i = 0; i < 16; i++) mx = fmaxf(mx, fabsf(v[i]));
    const float inv = mx > 0.f ? 6.f / mx : 0.f;
    unsigned n0 = 0u, n1 = 0u;
#pragma unroll
    for (int i = 0; i < 8; i++) {
      n0 |= fp4_code(v[i], inv) << (4 * i);
      n1 |= fp4_code(v[8 + i], inv) << (4 * i);
    }
    unsigned* dp = (unsigned*)(dst + (size_t)row * 768 + lane * 12);
    dp[0] = n0; dp[1] = n1; dp[2] = __float_as_uint(mx * (1.f / 6.f));
  }
}
__device__ __forceinline__ void axpy16_fp4(const uint3 r, float a, f32x2v* acc) {
  const float w = a * __uint_as_float(r.z);
  const f32x2v wv = {w, w};
#define FP4_STEP(b)                                                                                                   \
  acc[b] = __builtin_elementwise_fma(wv, __builtin_amdgcn_cvt_scalef32_pk_f32_fp4(r.x, 1.0f, b), acc[b]);                \
  acc[4 + b] = __builtin_elementwise_fma(wv, __builtin_amdgcn_cvt_scalef32_pk_f32_fp4(r.y, 1.0f, b), acc[4 + b]);
  FP4_STEP(0) FP4_STEP(1) FP4_STEP(2) FP4_STEP(3)
#undef FP4_STEP
}
typedef unsigned u32x3v __attribute__((ext_vector_type(3)));
typedef u32x3v u32x3a4 __attribute__((aligned(4)));
typedef const __attribute__((address_space(1))) unsigned char* GAS_U8P;
typedef _Float16 h2v __attribute__((ext_vector_type(2)));
__device__ __forceinline__ void axpy16_fp4_h(const uint3 r, float a, h2v* acc) {
  const _Float16 wh = (_Float16)(a * __uint_as_float(r.z));
  const h2v wv = {wh, wh};
#define FP4H_STEP(b)                                                                                                  \
  acc[b] = __builtin_elementwise_fma(wv, __builtin_bit_cast(h2v, __builtin_amdgcn_cvt_scalef32_pk_f16_fp4(r.x, 1.0f, b)), acc[b]); \
  acc[4 + b] = __builtin_elementwise_fma(wv, __builtin_bit_cast(h2v, __builtin_amdgcn_cvt_scalef32_pk_f16_fp4(r.y, 1.0f, b)), acc[4 + b]);
  FP4H_STEP(0) FP4H_STEP(1) FP4H_STEP(2) FP4H_STEP(3)
#undef FP4H_STEP
}
#define PY_WSZ 16384
__device__ __forceinline__ void peer_experts_uv(const Params& p, const float* __restrict__ gx, const float* __restrict__ ssq,
                                                const float* __restrict__ gnext, int final, char* smem, int bid, int nb) {
  const int lane = tidx() & 63, wid = tidx() >> 6;
  const bool b0 = lane & 1, b1 = (lane >> 1) & 1, b2 = (lane >> 2) & 1;
  const int myu = 4 * (int)b0 + 2 * (int)b1 + (int)b2;
  int* se = (int*)(smem + wid * PY_WSZ);
  float* sg = (float*)(smem + wid * PY_WSZ + 4096);
  float* sa = (float*)(smem + wid * PY_WSZ + 8192);
  float* ssc = (float*)(smem + wid * PY_WSZ + 12288);
  const unsigned long long ltmask = (1ull << lane) - 1ull;
  const unsigned lane12 = (unsigned)lane * 12u;
  for (int tt = bid * 4 + wid; tt < T_ / 8; tt += nb * 4) {
    const int t = __builtin_amdgcn_readfirstlane(tt) * 8;
    int ev0[8], ev1[8];
    float gv0[8], gv1[8];
#pragma unroll
    for (int j = 0; j < 8; j++) {
      ev0[j] = p.EIDX[(size_t)(t + j) * 128 + lane]; ev1[j] = p.EIDX[(size_t)(t + j) * 128 + 64 + lane];
      gv0[j] = p.GATE[(size_t)(t + j) * 128 + lane]; gv1[j] = p.GATE[(size_t)(t + j) * 128 + 64 + lane];
    }
#define PY_DECL(S) uint4 S##r0, S##r1, S##r2, S##r3, S##r4, S##r5, S##r6, S##r7;
#define PY_LD1(S, TAB, n, kk) S##r##n = *(const uint4*)(TAB + (size_t)__builtin_amdgcn_readfirstlane(se[(kk) + n]) * DM + lane * 16);
#define PY_LOAD(S, TAB, kk) { PY_LD1(S, TAB, 0, kk) PY_LD1(S, TAB, 1, kk) PY_LD1(S, TAB, 2, kk) PY_LD1(S, TAB, 3, kk) \
                              PY_LD1(S, TAB, 4, kk) PY_LD1(S, TAB, 5, kk) PY_LD1(S, TAB, 6, kk) PY_LD1(S, TAB, 7, kk) }
    {
      uint2 xq[8];
      float xsv[8];
      {
        float gv[16];
#pragma unroll
        for (int c = 0; c < 4; c++) {
          const float4 g4 = *(const float4*)(gx + lane * 16 + 4 * c);
          gv[4 * c] = g4.x; gv[4 * c + 1] = g4.y; gv[4 * c + 2] = g4.z; gv[4 * c + 3] = g4.w;
        }
#pragma unroll
        for (int j = 0; j < 8; j++) {
          const float* hp = p.out + (size_t)(t + j) * DM + lane * 16;
          const float sx = rsqrtf(ssq_sum<16>(ssq, t + j) * (1.f / DM) + 1e-6f);
          float xv[16];
#pragma unroll
          for (int c = 0; c < 4; c++) {
            const float4 a4 = *(const float4*)(hp + 4 * c);
            xv[4 * c] = a4.x * sx * gv[4 * c]; xv[4 * c + 1] = a4.y * sx * gv[4 * c + 1];
            xv[4 * c + 2] = a4.z * sx * gv[4 * c + 2]; xv[4 * c + 3] = a4.w * sx * gv[4 * c + 3];
          }
          float mx = 0.f;
#pragma unroll
          for (int i = 0; i < 16; i++) mx = fmaxf(mx, fabsf(xv[i]));
          const float inv = mx > 0.f ? 7.f / mx : 0.f;
          xsv[j] = mx * (1.f / 7.f);
          unsigned q0 = 0u, q1 = 0u;
#pragma unroll
          for (int i = 0; i < 8; i++) {
            q0 |= ((unsigned)__float2int_rn(xv[i] * inv) & 15u) << (4 * i);
            q1 |= ((unsigned)__float2int_rn(xv[8 + i] * inv) & 15u) << (4 * i);
          }
          xq[j] = make_uint2(q0, q1);
        }
      }
#pragma unroll
      for (int j = 0; j < 8; j++) {
        const int e0 = ev0[j], e1 = ev1[j];
        const float g0 = gv0[j], g1 = gv1[j];
        const int k0 = e0 >> 11, k1 = e1 >> 11;
        int base = 0, pos0 = 0, pos1 = 0;
#pragma unroll
        for (int k = 0; k < 8; k++) {
          const unsigned long long m0 = __ballot(k0 == k), m1 = __ballot(k1 == k);
          const int c0 = __popcll(m0);
          if (k0 == k) pos0 = base + __popcll(m0 & ltmask);
          if (k1 == k) pos1 = base + c0 + __popcll(m1 & ltmask);
          base += c0 + __popcll(m1);
        }
        se[j * 128 + pos0] = e0 * 768; sg[j * 128 + pos0] = g0;
        se[j * 128 + pos1] = e1 * 768; sg[j * 128 + pos1] = g1;
      }
#define PY_DOTS(S, X, XS, kk)                                                                                              \
  {                                                                                                                      \
    const float d0 = dot16_q4(S##u0, X, XS), d1 = dot16_q4(S##u1, X, XS), d2 = dot16_q4(S##u2, X, XS), d3 = dot16_q4(S##u3, X, XS); \
    const float d4 = dot16_q4(S##u4, X, XS), d5 = dot16_q4(S##u5, X, XS), d6 = dot16_q4(S##u6, X, XS), d7 = dot16_q4(S##u7, X, XS); \
    const float e0 = (b0 ? d4 : d0) + DPP_F((b0 ? d0 : d4), 0xB1);                                                       \
    const float e1 = (b0 ? d5 : d1) + DPP_F((b0 ? d1 : d5), 0xB1);                                                       \
    const float e2 = (b0 ? d6 : d2) + DPP_F((b0 ? d2 : d6), 0xB1);                                                       \
    const float e3 = (b0 ? d7 : d3) + DPP_F((b0 ? d3 : d7), 0xB1);                                                       \
    const float f0 = (b1 ? e2 : e0) + DPP_F((b1 ? e0 : e2), 0x4E);                                                       \
    const float f1 = (b1 ? e3 : e1) + DPP_F((b1 ? e1 : e3), 0x4E);                                                       \
    float gs = (b2 ? f1 : f0) + SWZ_F((b2 ? f0 : f1), 0x101F);                                                           \
    gs += DPP_F(gs, 0x128);                                                                                              \
    gs += SWZ_F(gs, 0x401F);                                                                                             \
    gs += __shfl_xor(gs, 32);                                                                                            \
    if (lane < 8) sa[(kk) + myu] = gs;     \
  }
#define PU_DECL(S) uint3 S##u0, S##u1, S##u2, S##u3, S##u4, S##u5, S##u6, S##u7;
#define PU_LD1(S, n, kk) { const u32x3a4 t_ = *(const __attribute__((address_space(1))) u32x3a4*)((GAS_U8P)p.PU8 + ((unsigned)se[(kk) + n] + lane12)); \
                           S##u##n = make_uint3(t_.x, t_.y, t_.z); }
#define PU_LOAD(S, kk) { PU_LD1(S, 0, kk) PU_LD1(S, 1, kk) PU_LD1(S, 2, kk) PU_LD1(S, 3, kk) \
                         PU_LD1(S, 4, kk) PU_LD1(S, 5, kk) PU_LD1(S, 6, kk) PU_LD1(S, 7, kk) }
      PU_DECL(A) PU_DECL(B)
      PU_LOAD(A, 0)
#pragma unroll 1
      for (int g8 = 0; g8 < 128; g8 += 8) {
#pragma unroll
        for (int q = 0; q < 4; q++) {
          PU_LOAD(B, (2 * q + 1) * 128 + g8)
          PY_DOTS(A, xq[2 * q], xsv[2 * q], (2 * q) * 128 + g8)
          if (q < 3) { PU_LOAD(A, (2 * q + 2) * 128 + g8) }
          else if (g8 + 8 < 128) { PU_LOAD(A, g8 + 8) }
          PY_DOTS(B, xq[2 * q + 1], xsv[2 * q + 1], (2 * q + 1) * 128 + g8)
        }
      }
#undef PY_DOTS
#pragma unroll
      for (int j = 0; j < 8; j++) {
#pragma unroll
        for (int hh = 0; hh < 2; hh++) {
          const int idx = j * 128 + hh * 64 + lane;
          const float z_ = sa[idx];
          sa[idx] = 0.5f * z_ * (1.f + erff(z_ * 0.70710678118654752f)) * sg[idx];
        }
      }
#undef PU_DECL
#undef PU_LD1
#undef PU_LOAD
    }
#define PV_DECL(S) uint3 S##v0, S##v1, S##v2, S##v3, S##v4, S##v5, S##v6, S##v7;
#define PV_LD1(S, n, kk) { const u32x3a4 t_ = *(const __attribute__((address_space(1))) u32x3a4*)((GAS_U8P)p.PV8 + ((unsigned)se[(kk) + n] + lane12)); \
                           S##v##n = make_uint3(t_.x, t_.y, t_.z); }
#define PV_LOAD(S, kk) { PV_LD1(S, 0, kk) PV_LD1(S, 1, kk) PV_LD1(S, 2, kk) PV_LD1(S, 3, kk) \
                         PV_LD1(S, 4, kk) PV_LD1(S, 5, kk) PV_LD1(S, 6, kk) PV_LD1(S, 7, kk) }
#define PY_AXPY(S, ACC, kk)                                                                                              \
  {                                                                                                                      \
    axpy16_fp4_h(S##v0, sa[(kk) + 0], ACC); axpy16_fp4_h(S##v1, sa[(kk) + 1], ACC);                                      \
    axpy16_fp4_h(S##v2, sa[(kk) + 2], ACC); axpy16_fp4_h(S##v3, sa[(kk) + 3], ACC);                                      \
    axpy16_fp4_h(S##v4, sa[(kk) + 4], ACC); axpy16_fp4_h(S##v5, sa[(kk) + 5], ACC);                                      \
    axpy16_fp4_h(S##v6, sa[(kk) + 6], ACC); axpy16_fp4_h(S##v7, sa[(kk) + 7], ACC);                                      \
  }
#define PY_EPI(HP, CV, j)                                                                                                \
  {                                                                                                                      \
    float hv[16], gv[16];                                                                                                \
    _Pragma("unroll") for (int c = 0; c < 4; c++) {                                                                      \
      const float4 a4 = *(const float4*)(HP + 4 * c);                                                                    \
      const float4 g4 = *(const float4*)(gnext + lane * 16 + 4 * c);                                                     \
      hv[4 * c] = a4.x; hv[4 * c + 1] = a4.y; hv[4 * c + 2] = a4.z; hv[4 * c + 3] = a4.w;                                \
      gv[4 * c] = g4.x; gv[4 * c + 1] = g4.y; gv[4 * c + 2] = g4.z; gv[4 * c + 3] = g4.w;                                \
    }                                                                                                                    \
    float ss = 0.f;                                                                                                      \
    _Pragma("unroll") for (int i = 0; i < 16; i++) { hv[i] += (float)CV[i >> 1][i & 1]; ss += hv[i] * hv[i]; }                  \
    ss = wave_sum(ss);                                                                                                   \
    const float sc = rsqrtf(ss * (1.f / DM) + 1e-6f);                                                                    \
    if (final) {                                                                                                         \
      _Pragma("unroll") for (int c = 0; c < 4; c++)                                                                      \
        *(float4*)(HP + 4 * c) = make_float4(hv[4 * c] * sc * gv[4 * c], hv[4 * c + 1] * sc * gv[4 * c + 1],            \
                                             hv[4 * c + 2] * sc * gv[4 * c + 2], hv[4 * c + 3] * sc * gv[4 * c + 3]);    \
    } else {                                                                                                             \
      _Pragma("unroll") for (int c = 0; c < 4; c++)                                                                      \
        *(float4*)(HP + 4 * c) = make_float4(hv[4 * c], hv[4 * c + 1], hv[4 * c + 2], hv[4 * c + 3]);                    \
      float nv[16];                                                                                                      \
      _Pragma("unroll") for (int i = 0; i < 16; i++) nv[i] = hv[i] * sc * gv[i];                                         \
      bf16_t* xo = p.XN + (size_t)(t + j) * DM + lane * 16;                                                              \
      store8bf(xo, nv);                                                                                                  \
      store8bf(xo + 8, nv + 8);                                                                                          \
    }                                                                                                                    \
  }
#pragma unroll 1
    for (int q = 0; q < 2; q++) {
      const int lb = (4 * q) * 128;
      float* hp0 = p.out + (size_t)(t + 4 * q) * DM + lane * 16;
      h2v c0[8], c1[8], c2[8], c3[8];
#pragma unroll
      for (int j = 0; j < 8; j++) { c0[j] = (h2v){(_Float16)0.f, (_Float16)0.f}; c1[j] = c0[j]; c2[j] = c0[j]; c3[j] = c0[j]; }
      PV_DECL(A) PV_DECL(B)
      PV_LOAD(A, lb)
#pragma unroll 1
      for (int k0 = 0; k0 < 128; k0 += 8) {
        PV_LOAD(B, lb + 128 + k0)
        PY_AXPY(A, c0, lb + k0)
        PV_LOAD(A, lb + 256 + k0)
        PY_AXPY(B, c1, lb + 128 + k0)
        PV_LOAD(B, lb + 384 + k0)
        PY_AXPY(A, c2, lb + 256 + k0)
        if (k0 + 8 < 128) PV_LOAD(A, lb + k0 + 8)
        PY_AXPY(B, c3, lb + 384 + k0)
      }
      PY_EPI(hp0, c0, 4 * q)
      PY_EPI((hp0 + DM), c1, 4 * q + 1)
      PY_EPI((hp0 + 2 * DM), c2, 4 * q + 2)
      PY_EPI((hp0 + 3 * DM), c3, 4 * q + 3)
    }
#undef PY_AXPY
#undef PV_DECL
#undef PV_LD1
#undef PV_LOAD
#undef PY_EPI
#undef PY_DECL
#undef PY_LD1
#undef PY_LOAD
  }
}

#define XB_TMO      128
#define XB_XCNT(j)  (256  + 64 * (j))
#define XB_XSUB(j)  (1280 + 64 * (j))
#define XB_XGEN(j)  (2304 + 64 * (j))
#define XB_TOP      3328
#define XB_TOPGEN   3392
#define XCD_BAR_WORDS 3456
#define XB_SPIN_CAP (1u << 18)
#define LAS __attribute__((address_space(3)))

__device__ __forceinline__ unsigned xb_ld(unsigned* p)              { return __hip_atomic_load(p, __ATOMIC_RELAXED, __HIP_MEMORY_SCOPE_AGENT); }
__device__ __forceinline__ unsigned xb_add(unsigned* p, unsigned v) { return __hip_atomic_fetch_add(p, v, __ATOMIC_RELAXED, __HIP_MEMORY_SCOPE_AGENT); }
__device__ __forceinline__ unsigned xb_xcc_id() { return (unsigned)__builtin_amdgcn_s_getreg((3 << 11) | 20) & 0xFu; }
#define XB_SPIN(cond, bar) do { unsigned _sp = 0; while (cond) { __builtin_amdgcn_s_sleep(1); \
    if ((++_sp & 255u) == 0u) { if (xb_ld(&(bar)[XB_TMO])) break; if (_sp > XB_SPIN_CAP) { atomicAdd(&(bar)[XB_TMO], 1u); break; } } } } while (0)

struct XcdBarrier {
    unsigned* bar; unsigned x;
    volatile LAS unsigned* st;
};

__device__ __forceinline__ XcdBarrier xcd_barrier_post(unsigned* bar, volatile LAS unsigned* st) {
    XcdBarrier b; b.bar = bar; b.x = xb_xcc_id(); b.st = st;
    if (tidx() == 0) (void)xb_add(&bar[XB_XCNT(b.x)], 1u);
    return b;
}
__device__ __forceinline__ void xcd_barrier_complete(unsigned* bar, unsigned x, unsigned& nloc, unsigned& nx) {
    const unsigned G = gridDim.x * gridDim.y * gridDim.z;
    unsigned sum, cnt, mine, sp = 0u;
    for (;;) {
        sum = 0u; cnt = 0u; mine = 0u;
#pragma unroll
        for (unsigned j = 0; j < 16; ++j) { const unsigned c = xb_ld(&bar[XB_XCNT(j)]); sum += c; cnt += (c > 0u) ? 1u : 0u; mine = (j == x) ? c : mine; }
        if (sum == G) break;
        __builtin_amdgcn_s_sleep(1);
        if ((++sp & 255u) == 0u) { if (xb_ld(&bar[XB_TMO])) break; if (sp > XB_SPIN_CAP) { atomicAdd(&bar[XB_TMO], 1u); break; } }
    }
    nloc = mine > 0u ? mine : 1u; nx = cnt > 0u ? cnt : 1u;
}

__device__ __forceinline__ void xcd_barrier(const XcdBarrier& b) {
    asm volatile("s_waitcnt vmcnt(0)" ::: "memory");
    __syncthreads();
    if (tidx() == 0) {
        unsigned* bar = b.bar;
        __builtin_amdgcn_s_waitcnt(0);
        unsigned nloc = b.st[0], nx = b.st[1];
        if (nloc == 0u) { xcd_barrier_complete(bar, b.x, nloc, nx); b.st[0] = nloc; b.st[1] = nx; }
        const unsigned old = xb_add(&bar[XB_XSUB(b.x)], 1u);
        const unsigned gen = old / nloc;
        if (old + 1u == (gen + 1u) * nloc) {
            __builtin_amdgcn_fence(__ATOMIC_RELEASE, "agent");
            asm volatile("s_waitcnt vmcnt(0)" ::: "memory");
            const unsigned og = xb_add(&bar[XB_TOP], 1u);
            const unsigned tg = og / nx;
            if (og + 1u == (tg + 1u) * nx) xb_add(&bar[XB_TOPGEN], 1u);
            else XB_SPIN(xb_ld(&bar[XB_TOPGEN]) == tg, bar);
            __builtin_amdgcn_fence(__ATOMIC_ACQUIRE, "agent");
            xb_add(&bar[XB_XGEN(b.x)], 1u);
            asm volatile("s_waitcnt vmcnt(0)" ::: "memory");
        } else {
            XB_SPIN(xb_ld(&bar[XB_XGEN(b.x)]) == gen, bar);
            __builtin_amdgcn_fence(__ATOMIC_ACQUIRE, "agent");
            asm volatile("s_waitcnt vmcnt(0)" ::: "memory");
        }
    }
    __syncthreads();
}


#define NPHASES 14

template <int PH>
__device__ __forceinline__ void run_phase(const Params& p, char* smem, int bid, int nb) {
  float* fl = (float*)smem;
  if constexpr (PH == 0) {
    transpose_w(p.ev_w_in, 1024, 4608, p.WT_in, 4608, fl, bid, nb);
    transpose_w(p.ev_w_o, 1536, 1024, p.WT_o0, 1024, fl, bid, nb);
    transpose_w(p.od_w_down, 1024, 800, p.WT_down, 896, fl, bid, nb);
    transpose_w(p.od_w_uq, 512, 1536, p.WT_uq, 1536, fl, bid, nb, p.od_q_norm);
    transpose_w(p.od_w_ukv, 256, 2048, p.WT_ukv, 2048, fl, bid, nb, p.od_kv_norm);
    transpose_w(p.od_w_o, 1024, 1024, p.WT_o1, 1024, fl, bid, nb);
    transpose_w(p.peer_wq, 1024, 1024, p.WT_pq, 1024, fl, bid, nb, p.ffn_norm);
    transpose_w(p.peer_wq + 1024 * 1024, 1024, 1024, p.WT_pq + 1024 * 1024, 1024, fl, bid, nb, p.ffn_norm + 1024);
    rope_tables(p.COSM, p.SINM, 8, 500000.0, bid, nb);
    rope_tables(p.COSR, p.SINR, 32, 10000.0, bid, nb);
    rope_tables(p.COSL, p.SINL, 16, 500000.0, bid, nb);
    convert_bf16(p.peer_keys, p.PKEYS, (size_t)2 * 8 * 2 * 128 * 64, bid, nb);
    rmsnorm_rows(p.x, p.attn_norm, p.XN, bid, nb);
    if (bid == 0) { p.GCNT[tidx()] = 0u; p.GCNT[256 + tidx()] = 0u; }
  }
  if constexpr (PH == 1) {
    const bool cf = (bid >> 8) & 1;
    if (cf) {
      convert_q4_rows(p.peer_u, p.PU8, 16384, bid, nb);
      convert_fp4_rows(p.peer_v, p.PV8, 16384, bid, nb);
    }
    gemm_mfma(p.XN, 1024, p.WT_in, 1024, T_, 4608, 1024,
              EpiInProj{p.MQ, p.MK, p.MVT, p.RQ, p.RK, p.RKTZ, p.RVT, p.RG, p.COSM, p.SINM, p.COSR, p.SINR}, smem, bid, nb);
    if (!cf) {
      convert_q4_rows(p.peer_u, p.PU8, 16384, bid, nb);
      convert_fp4_rows(p.peer_v, p.PV8, 16384, bid, nb);
    }
  }
  if constexpr (PH == 2) {
    moba_kmean(p, bid, nb);
    retention_state(p, bid, nb);
  }
  if constexpr (PH == 3) {
    moba_select(p, smem, bid, nb);
    retention_prefix(p, bid, nb);
  }
  if constexpr (PH == 4) {
    moba_gathered(p, smem, bid, nb);
    retention_out(p, smem, bid, nb);
  }
  if constexpr (PH == 5) { moba_own_merge(p, smem, bid, nb); }
  if constexpr (PH == 6) { gemm_mfma(p.CAT, 1536, p.WT_o0, 1536, T_, 1024, 1536, EpiResSSQ{p.x, p.out, p.XN, p.SSQ0}, smem, bid, nb); }
  if constexpr (PH == 7) { gemm_mfma(p.XN, 1024, p.WT_pq, 1024, T_, 1024, 1024, EpiRoute{&p, p.SSQ0, 0, smem}, smem, bid, nb); }
  if constexpr (PH == 8) { peer_experts_uv(p, p.ffn_norm, p.SSQ0, p.attn_norm + 1024, 0, smem, bid, nb); }
  if constexpr (PH == 9) {
    gemm_mfma(p.XN, 1024, p.WT_down, 1024, T_, 896, 1024, EpiDown{p.CQN, p.CKVN, p.K1, p.SSQQ, p.SSQKV, p.COSL, p.SINL}, smem, bid, nb);
  }
  if constexpr (PH == 10) {
    gemm_mfma(p.CQN, 512, p.WT_uq, 512, T_, 1536, 512, EpiUQ{p.Q1, p.COSL, p.SINL, p.SSQQ}, smem, bid, nb);
    gemm_mfma(p.CKVN, 256, p.WT_ukv, 256, T_, 2048, 256, EpiUKV{p.K1, p.V1T, p.SSQKV}, smem, bid, nb);
  }
  if constexpr (PH == 11) {
    const bool cf = (bid >> 8) & 1;
    if (cf) {
      convert_q4_rows(p.peer_u + (size_t)16384 * 1024, p.PU8, 16384, bid, nb);
      convert_fp4_rows(p.peer_v + (size_t)16384 * 1024, p.PV8, 16384, bid, nb);
    }
    attn_causal<96>(p.Q1, p.K1, p.V1T, p.O1, 1024, 16, smem, bid, nb);
    if (!cf) {
      convert_q4_rows(p.peer_u + (size_t)16384 * 1024, p.PU8, 16384, bid, nb);
      convert_fp4_rows(p.peer_v + (size_t)16384 * 1024, p.PV8, 16384, bid, nb);
    }
  }
  if constexpr (PH == 12) { gemm_mfma(p.O1, 1024, p.WT_o1, 1024, T_, 1024, 1024, EpiResSSQ{p.out, p.out, p.XN, p.SSQ1}, smem, bid, nb); }
  if constexpr (PH == 13) { gemm_mfma(p.XN, 1024, p.WT_pq + 1024 * 1024, 1024, T_, 1024, 1024, EpiRoute{&p, p.SSQ1, 1, smem}, smem, bid, nb); }
  if constexpr (PH == 14) { peer_experts_uv(p, p.ffn_norm + 1024, p.SSQ1, p.final_norm, 1, smem, bid, nb); }
}

#define SMEM_BYTES 65536

template <int PH>
__global__ void __launch_bounds__(NTHREADS, 2) mk1(Params p) {
  __shared__ __attribute__((aligned(16))) char smem[SMEM_BYTES];
  run_phase<PH>(p, smem, blockIdx.x, gridDim.x);
}

#if MEGA
typedef const __attribute__((address_space(4))) Params CParams;
__device__ __forceinline__ CParams* kernarg_params() {
  CParams* cp = (CParams*)__builtin_amdgcn_kernarg_segment_ptr();
  asm volatile("" : "+s"(cp));
  return cp;
}

template <int PH>
__device__ __forceinline__ void phase_seq(char* smem, volatile LAS unsigned* xbw) {
#ifdef __HIP_DEVICE_COMPILE__
  {
    const Params q = *kernarg_params();
    run_phase<PH>(q, smem, blockIdx.x, gridDim.x);
  }
  if constexpr (PH < NPHASES) {
    {
      XcdBarrier xb;
      xb.bar = kernarg_params()->BAR;
      xb.x = xb_xcc_id();
      xb.st = xbw;
      xcd_barrier(xb);
    }
    phase_seq<PH + 1>(smem, xbw);
  }
#endif
}

__global__ void __launch_bounds__(NTHREADS, 2) mk(Params p) {
  __shared__ __attribute__((aligned(16))) char smem[SMEM_BYTES];
  __shared__ uint4 xb_words;
#ifdef __HIP_DEVICE_COMPILE__
  if (tidx() == 0) xb_words = make_uint4(0u, 0u, 0u, 0u);
  __syncthreads();
  (void)xcd_barrier_post(kernarg_params()->BAR, (volatile LAS unsigned*)&xb_words);
  if (gridDim.x == 0x7fffffffu) cg::this_grid().sync();
  phase_seq<0>(smem, (volatile LAS unsigned*)&xb_words);
#endif
}
#else
template <int PH>
static void launch_seq(const Params& p, int grid_blocks, hipStream_t stream) {
  hipLaunchKernelGGL(mk1<PH>, dim3(grid_blocks), dim3(NTHREADS), 0, stream, p);
  if constexpr (PH < NPHASES) launch_seq<PH + 1>(p, grid_blocks, stream);
}

#endif

extern "C" void kernel_launch(void* const* d_in, const int* in_sizes, int n_in, void* d_out, int out_size, void* d_ws,
                              size_t ws_size, hipStream_t stream) {
  Params p;
  memset(&p, 0, sizeof(p));
  p.x = (const float*)d_in[0];
  p.attn_norm = (const float*)d_in[1];
  p.ffn_norm = (const float*)d_in[2];
  p.ev_w_in = (const float*)d_in[3];
  p.ev_ret_gn = (const float*)d_in[4];
  p.ev_w_o = (const float*)d_in[5];
  p.od_w_down = (const float*)d_in[6];
  p.od_q_norm = (const float*)d_in[7];
  p.od_w_uq = (const float*)d_in[8];
  p.od_kv_norm = (const float*)d_in[9];
  p.od_w_ukv = (const float*)d_in[10];
  p.od_w_o = (const float*)d_in[11];
  p.peer_wq = (const float*)d_in[12];
  p.peer_keys = (const float*)d_in[13];
  p.peer_u = (const float*)d_in[14];
  p.peer_v = (const float*)d_in[15];
  p.final_norm = (const float*)d_in[16];
  p.out = (float*)d_out;

  char* w = (char*)d_ws;
  size_t off = 0;
  auto take = [&](size_t bytes) {
    char* r = w + off;
    off += (bytes + 255) & ~(size_t)255;
    return r;
  };
  const size_t T = T_;
  p.WT_in = (bf16_t*)take(4608 * 1024 * 2);
  p.WT_o0 = (bf16_t*)take(1024 * 1536 * 2);
  p.WT_down = (bf16_t*)take(896 * 1024 * 2);
  p.WT_uq = (bf16_t*)take(1536 * 512 * 2);
  p.WT_ukv = (bf16_t*)take(2048 * 256 * 2);
  p.WT_o1 = (bf16_t*)take(1024 * 1024 * 2);
  p.WT_pq = (bf16_t*)take(2 * 1024 * 1024 * 2);
  p.PU8 = (unsigned char*)take(T * 1024);
  p.PV8 = (unsigned char*)take(T * 1024);
  p.PUS = (float*)take(T * 4);
  p.PKEYS = (bf16_t*)take(2 * 8 * 2 * 128 * 64 * 2);
  p.COSM = (float*)take(T * 8 * 4);
  p.SINM = (float*)take(T * 8 * 4);
  p.COSR = (float*)take(T * 32 * 4);
  p.SINR = (float*)take(T * 32 * 4);
  p.COSL = (float*)take(T * 16 * 4);
  p.SINL = (float*)take(T * 16 * 4);
  p.XN = (bf16_t*)take(T * 1024 * 2);
  p.EIDX = (int*)take(T * 128 * 4);
  p.GATE = (float*)take(T * 128 * 4);
  p.KMEAN = (float*)take(8 * 64 * 64 * 4);
  p.BAR = (unsigned*)take(XCD_BAR_WORDS * 4);
  p.GCNT = (unsigned*)take(512 * 4);
  p.SSQ0 = (float*)take(T * 16 * 4 * 4);
  p.SSQ1 = p.SSQ0 + T * 16;
  p.SSQQ = p.SSQ0 + 2 * T * 16;
  p.SSQKV = p.SSQ0 + 3 * T * 16;
  const size_t base = off;
  p.MQ = (bf16_t*)take(T * 512 * 2);
  p.MK = (bf16_t*)take(T * 512 * 2);
  p.MVT = (bf16_t*)take(T * 512 * 2);
  p.RQ = (bf16_t*)take(T * 512 * 2);
  p.RK = (bf16_t*)take(T * 512 * 2);
  p.RKTZ = (bf16_t*)take(T * 512 * 2);
  p.RVT = (bf16_t*)take(T * 1024 * 2);
  p.RG = (bf16_t*)take(T * 1024 * 2);
  p.CAT = (bf16_t*)take(T * 1536 * 2);
  p.SST = (float*)take((size_t)8 * 128 * 128 * 64 * 4);
  p.RT = (bf16_t*)take((size_t)8 * 128 * 128 * 64 * 2);
  p.MLIST = (unsigned*)take((size_t)512 * MOBA_LSTRIDE * 4);
  p.PO = (bf16_t*)take(T * 8 * 3 * 64 * 2);
  p.PML = (float*)take(T * 8 * 3 * 2 * 4);
  off = base;
  p.CQN = (bf16_t*)take(T * 512 * 2);
  p.CKVN = (bf16_t*)take(T * 256 * 2);
  p.Q1 = (bf16_t*)take(T * 1536 * 2);
  p.K1 = (bf16_t*)take(T * 1536 * 2);
  p.V1T = (bf16_t*)take(T * 1024 * 2);
  p.O1 = (bf16_t*)take(T * 1024 * 2);

  static int grid_blocks = 0;
  if (!grid_blocks) {
    int dev = 0, cus = 0, per_cu = 0;
    (void)hipGetDevice(&dev);
    (void)hipDeviceGetAttribute(&cus, hipDeviceAttributeMultiprocessorCount, dev);
#if MEGA
    (void)hipOccupancyMaxActiveBlocksPerMultiprocessor(&per_cu, mk, NTHREADS, 0);
#else
    per_cu = 2;
#endif
    if (per_cu > 2) per_cu = 2;
    if (per_cu < 1) per_cu = 1;
    grid_blocks = cus * per_cu;
  }
#if MEGA
  (void)hipMemsetAsync(p.BAR, 0, XCD_BAR_WORDS * 4, stream);
  void* args[] = {&p};
  hipError_t e = hipLaunchCooperativeKernel((void*)mk, dim3(grid_blocks), dim3(NTHREADS), args, 0, stream);
  if (e != hipSuccess) fprintf(stderr, "cooperative launch failed: %s (grid %d)\n", hipGetErrorString(e), grid_blocks);
#else
  launch_seq<0>(p, grid_blocks, stream);
#endif
}
```
